# Optimizing an MI355X kernel written in HIP

```python
import math
import jax, jax.numpy as jnp
from jax import lax
import numpy as np

D_MODEL = 1024
BATCH = 16
SEQ = 2048
DEPTH = 1

CTX_LEN = 256
GRID_W = 64
D_MIX = D_MODEL
D_ATTN = D_MIX // 2
D_CONV = D_MIX - D_ATTN
HEAD_DIM = 64
N_Q_HEADS = D_ATTN // HEAD_DIM
N_KV_HEADS = 2
GROUP = N_Q_HEADS // N_KV_HEADS
ROPE_AXIS_DIM = HEAD_DIM // 2
ROPE_THETA = 10000.0
Q_BLOCK = 128
CONV_WIDTH = 31
CONV_PAD = (CONV_WIDTH - 1) // 2
EPS = 1e-6

Q_LO, Q_HI = 0, D_ATTN
K_LO, K_HI = Q_HI, Q_HI + N_KV_HEADS * HEAD_DIM
V_LO, V_HI = K_HI, K_HI + N_KV_HEADS * HEAD_DIM
ZA_LO, ZA_HI = V_HI, V_HI + D_ATTN
GLU_LO, GLU_HI = ZA_HI, ZA_HI + 2 * D_CONV
ZC_LO, ZC_HI = GLU_HI, GLU_HI + D_CONV
D_IN = ZC_HI

kernel_name = "hybrid_gqa_conformer_prefix_dit_layer"


def rms_norm(x, w):
    xf = x.astype(jnp.float32)
    y = xf * lax.rsqrt(jnp.mean(xf * xf, axis=-1, keepdims=True) + EPS)
    return (y * w.astype(jnp.float32)).astype(x.dtype)


def layer_norm(x, w, b):
    xf = x.astype(jnp.float32)
    mu = jnp.mean(xf, axis=-1, keepdims=True)
    var = jnp.mean(jnp.square(xf - mu), axis=-1, keepdims=True)
    y = (xf - mu) * lax.rsqrt(var + EPS)
    return (y * w.astype(jnp.float32) + b.astype(jnp.float32)).astype(x.dtype)


def grid_angles(n_tokens, dtype):
    rows = n_tokens // GRID_W
    row = jnp.repeat(jnp.arange(rows, dtype=jnp.float32), GRID_W)
    col = jnp.tile(jnp.arange(GRID_W, dtype=jnp.float32), rows)
    freqs = ROPE_THETA ** (-jnp.arange(0, ROPE_AXIS_DIM, 2, dtype=jnp.float32) / ROPE_AXIS_DIM)
    ang_r = row[:, None] * freqs[None, :]
    ang_c = col[:, None] * freqs[None, :]
    return (jnp.cos(ang_r).astype(dtype), jnp.sin(ang_r).astype(dtype),
            jnp.cos(ang_c).astype(dtype), jnp.sin(ang_c).astype(dtype))


def rope_axis(x, cos, sin):
    cos = cos[None, :, None, :]
    sin = sin[None, :, None, :]
    x1, x2 = jnp.split(x, 2, axis=-1)
    return jnp.concatenate([x1 * cos - x2 * sin, x1 * sin + x2 * cos], axis=-1)


def rope_2d(x, angles):
    cr, sr, cc, sc = angles
    return jnp.concatenate([rope_axis(x[..., :ROPE_AXIS_DIM], cr, sr),
                            rope_axis(x[..., ROPE_AXIS_DIM:], cc, sc)], axis=-1)


def qk_heads(p, qn_w, kn_w):
    B, S, _ = p.shape
    q = p[..., Q_LO:Q_HI].reshape(B, S, N_Q_HEADS, HEAD_DIM)
    k = p[..., K_LO:K_HI].reshape(B, S, N_KV_HEADS, HEAD_DIM)
    v = p[..., V_LO:V_HI].reshape(B, S, N_KV_HEADS, HEAD_DIM)
    return rms_norm(q, qn_w), rms_norm(k, kn_w), v


def kv_heads(p_kv, kn_w):
    B, S, _ = p_kv.shape
    kv = p_kv.reshape(B, S, 2, N_KV_HEADS, HEAD_DIM)
    return rms_norm(kv[:, :, 0], kn_w), kv[:, :, 1]


def attend_blocked(q, k, v):
    B, S, _, _ = q.shape
    scale = 1.0 / math.sqrt(HEAD_DIM)
    qb = q.reshape(B, S // Q_BLOCK, Q_BLOCK, N_KV_HEADS, GROUP, HEAD_DIM).transpose(1, 0, 2, 3, 4, 5)

    def one_block(qblk):
        s = jnp.einsum('bqkgd,bskd->bkgqs', qblk, k).astype(jnp.float32) * scale
        pr = jax.nn.softmax(s, axis=-1).astype(v.dtype)
        return jnp.einsum('bkgqs,bskd->bqkgd', pr, v)

    o = lax.map(one_block, qb)
    return o.transpose(1, 0, 2, 3, 4, 5).reshape(B, S, D_ATTN)


def attend_dense(q, k, v):
    B, C, _, _ = q.shape
    qg = q.reshape(B, C, N_KV_HEADS, GROUP, HEAD_DIM)
    s = jnp.einsum('bqkgd,bskd->bkgqs', qg, k).astype(jnp.float32) / math.sqrt(HEAD_DIM)
    pr = jax.nn.softmax(s, axis=-1).astype(v.dtype)
    return jnp.einsum('bkgqs,bskd->bqkgd', pr, v).reshape(B, C, D_ATTN)


def conformer_conv(glu_in, conv_w, conv_b, ln_w, ln_b, w_pw, b_pw):
    a, g = jnp.split(glu_in, 2, axis=-1)
    u = a * jax.nn.sigmoid(g)
    y = lax.conv_general_dilated(u, conv_w[:, None, :].astype(u.dtype), window_strides=(1,),
                                 padding=[(CONV_PAD, CONV_PAD)],
                                 dimension_numbers=('NWC', 'WIO', 'NWC'),
                                 feature_group_count=D_CONV) + conv_b
    y = jax.nn.silu(layer_norm(y, ln_w, ln_b))
    return y @ w_pw + b_pw


def setup_inputs(seed: int = 0) -> dict:
    key = jax.random.key(seed)
    ks = jax.random.split(key, 20)
    nrm = jax.random.normal
    f32 = jnp.float32
    return {
        "x": nrm(ks[0], (BATCH, SEQ, D_MODEL), f32),
        "c": nrm(ks[1], (BATCH, D_MODEL), f32),
        "ctx": nrm(ks[2], (BATCH, CTX_LEN, D_MODEL), f32),
        "c_ctx": nrm(ks[3], (D_MODEL,), f32),
        "w_mod": nrm(ks[4], (DEPTH, D_MODEL, 3 * D_MODEL), f32) * D_MODEL ** -0.5,
        "b_mod": nrm(ks[5], (DEPTH, 3 * D_MODEL), f32) * 0.02,
        "norm_w": 1.0 + 0.05 * nrm(ks[6], (DEPTH, D_MODEL), f32),
        "w_in": nrm(ks[7], (DEPTH, D_MODEL, D_IN), f32) * D_MODEL ** -0.5,
        "q_norm_w": 1.0 + 0.05 * nrm(ks[8], (DEPTH, HEAD_DIM), f32),
        "k_norm_w": 1.0 + 0.05 * nrm(ks[9], (DEPTH, HEAD_DIM), f32),
        "conv_w": nrm(ks[10], (DEPTH, CONV_WIDTH, D_CONV), f32) * CONV_WIDTH ** -0.5,
        "conv_b": nrm(ks[11], (DEPTH, D_CONV), f32) * 0.02,
        "conv_ln_w": 1.0 + 0.05 * nrm(ks[12], (DEPTH, D_CONV), f32),
        "conv_ln_b": nrm(ks[13], (DEPTH, D_CONV), f32) * 0.02,
        "w_pw": nrm(ks[14], (DEPTH, D_CONV, D_CONV), f32) * D_CONV ** -0.5,
        "b_pw": nrm(ks[15], (DEPTH, D_CONV), f32) * 0.02,
        "w_out": nrm(ks[16], (DEPTH, D_MIX, D_MODEL), f32) * D_MIX ** -0.5,
    }


def reference(x, c, ctx, c_ctx, w_mod, b_mod, norm_w, w_in, q_norm_w, k_norm_w,
              conv_w, conv_b, conv_ln_w, conv_ln_b, w_pw, b_pw, w_out):
    S = x.shape[1]
    angles = grid_angles(S, x.dtype)
    h, hc = x, ctx
    for l in range(DEPTH):
        mod = jax.nn.silu(c) @ w_mod[l] + b_mod[l]
        shift, scale, gate = jnp.split(mod, 3, axis=-1)
        mod_c = jax.nn.silu(c_ctx) @ w_mod[l] + b_mod[l]
        shift_c, scale_c, gate_c = jnp.split(mod_c, 3, axis=-1)

        u = rms_norm(h, norm_w[l]) * (1.0 + scale[:, None, :]) + shift[:, None, :]
        uc = rms_norm(hc, norm_w[l]) * (1.0 + scale_c) + shift_c

        p = u @ w_in[l]
        q, k, v = qk_heads(p, q_norm_w[l], k_norm_w[l])
        q = rope_2d(q, angles)
        k = rope_2d(k, angles)

        if l == DEPTH - 1:
            k_c, v_c = kv_heads(uc @ w_in[l][:, K_LO:V_HI], k_norm_w[l])
        else:
            pc = uc @ w_in[l]
            q_c, k_c, v_c = qk_heads(pc, q_norm_w[l], k_norm_w[l])
            attn_c = attend_dense(q_c, k_c, v_c) * jax.nn.silu(pc[..., ZA_LO:ZA_HI])
            conv_c = conformer_conv(pc[..., GLU_LO:GLU_HI], conv_w[l], conv_b[l], conv_ln_w[l],
                                    conv_ln_b[l], w_pw[l], b_pw[l]) * jax.nn.silu(pc[..., ZC_LO:ZC_HI])
            out_c = jnp.concatenate([attn_c, conv_c], axis=-1) @ w_out[l]

        k_all = jnp.concatenate([k_c, k], axis=1)
        v_all = jnp.concatenate([v_c, v], axis=1)
        attn = attend_blocked(q, k_all, v_all) * jax.nn.silu(p[..., ZA_LO:ZA_HI])

        conv = conformer_conv(p[..., GLU_LO:GLU_HI], conv_w[l], conv_b[l], conv_ln_w[l],
                              conv_ln_b[l], w_pw[l], b_pw[l]) * jax.nn.silu(p[..., ZC_LO:ZC_HI])

        out = jnp.concatenate([attn, conv], axis=-1) @ w_out[l]
        h = h + gate[:, None, :] * out
        if l < DEPTH - 1:
            hc = hc + gate_c * out_c
    return h
```

```cpp
#include <hip/hip_runtime.h>
#include <hip/hip_cooperative_groups.h>
#include <cstdio>
#include <cstdint>
namespace pg8 {
#define PG8_LAS __attribute__((address_space(3)))
typedef unsigned short bf16_t;
typedef short bf16x8 __attribute__((ext_vector_type(8)));
typedef float f32x4 __attribute__((ext_vector_type(4)));
typedef unsigned u32x4 __attribute__((ext_vector_type(4)));
constexpr int BM = 256, BK = 64, HALF = 128, HTB = HALF * BK * 2  , STAGE_BYTES = 8 * HTB, NXCD = 8, WGM = 8;

__host__ __device__ __forceinline__ int lds_byte(int r, int c) { const int st = (r >> 4) * 2 + (c >> 5), rr = r & 15, cc = c & 31, ob = rr * 64 + cc * 2; return st * 1024 + (ob ^ (((ob >> 9) & 1) << 5)); }
__host__ __device__ __forceinline__ void stage_rc(int b, int& R, int& C) { const int st = b / 1024, sb = b % 1024, swz = sb ^ (((sb >> 9) & 1) << 5); R = (st >> 1) * 16 + swz / 64; C = (st & 1) * 32 + (swz % 64) / 2; }
__host__ __device__ __forceinline__ int perm32(int rho) { const int n = rho >> 4, i = rho & 15; return 8 * (i >> 2) + 4 * n + (i & 3); }

struct Unit { int pm, pn; };
struct Gemm { const bf16_t* A; const bf16_t* Bt; int M, N, K; };

struct StaticOrder {
    int nM, nN, nwg, G, c;
    __host__ __device__ void init(int M, int N, int G_, int c_) { nM = M / BM; nN = N / BM; nwg = nM * nN; G = G_; c = c_; }
    __host__ __device__ bool next(int i, Unit& u) const {
        const long L = (long)i * G + c; if (L >= nwg) return false;
        int wgid = (int)L; { const int q = nwg / NXCD, r = nwg % NXCD, xcd = wgid % NXCD, off = wgid / NXCD; wgid = (xcd < r ? xcd * (q + 1) : r * (q + 1) + (xcd - r) * q) + off; }
        const int nig = WGM * nN, gid = wgid / nig, fm = gid * WGM, gsz = (nM - fm) < WGM ? (nM - fm) : WGM;
        u.pm = fm + ((wgid % nig) % gsz); u.pn = (wgid % nig) / gsz; return true;
    }
    __device__ __forceinline__ void a_ready(const Unit&) const {}
    __device__ __forceinline__ void done(const Unit&) const {}
};
__device__ __forceinline__ unsigned cvt_pk_bf16(float lo, float hi) { unsigned r; asm volatile("v_cvt_pk_bf16_f32 %0, %1, %2" : "=v"(r) : "v"(lo), "v"(hi)); return r; }
typedef float f32x2 __attribute__((ext_vector_type(2)));
constexpr float QC2 = 0.125f * 1.4426950408889634f;
__device__ __forceinline__ float silu_f(float v) { return v * __builtin_amdgcn_rcpf(1.0f + __expf(-v)); }
__device__ __forceinline__ float sigm_f(float v) { return __builtin_amdgcn_rcpf(1.0f + __expf(-v)); }
__device__ __forceinline__ float bf_lo(unsigned w) { return __uint_as_float(w << 16); }
__device__ __forceinline__ float bf_hi(unsigned w) { return __uint_as_float(w & 0xffff0000u); }

struct OrderIn {
    StaticOrder so;
    __device__ void init(int G_, int c_) { so.init(32768, 2816, G_, c_); }
    __device__ bool next(int i, Unit& u) const {
        const long L = (long)i * so.G + so.c;
        if (L < so.nwg) return so.next(i, u);
        const int e = (int)(L - so.nwg); if (e >= 16) return false;
        u.pm = 128 + e; u.pn = 2; return true;
    }
    __device__ __forceinline__ void a_ready(const Unit&) const {}
    __device__ __forceinline__ void done(const Unit&) const {}
};

struct EpiIn {
    static constexpr bool PERM = true, AFTER_DRAIN = false;
    bf16_t *Q, *KA, *VA, *Z, *UG; const float* rope; const float *qnw, *knw;
    __device__ __forceinline__ void operator()(const f32x4 (&acc)[2][2][4][2], const Unit& u, int wr, int wc, int fr, int fq) const {
        const int pn = u.pn;
        const int rowb = u.pm * BM + wr * 64 + fr;
        if (pn <= 2) {
            const bool isq = pn < 2, isv = (pn == 2) && (wc >= 2), isctx = u.pm >= 128;
            const int d1 = (fq & 1) * 8 + (fq >> 1) * 32;
            float w1[8], w2[8];
            { const float* nw = isq ? qnw : knw; const float sc = isq ? QC2 : 1.0f;
#pragma unroll
              for (int e = 0; e < 8; ++e) { w1[e] = nw[d1 + e] * sc; w2[e] = nw[d1 + 16 + e] * sc; } }
#pragma unroll
            for (int ai = 0; ai < 2; ++ai)
#pragma unroll
                for (int m = 0; m < 4; ++m) {
                    const int row = rowb + ai * HALF + m * 16;
                    float x1[8], x2[8];
#pragma unroll
                    for (int n = 0; n < 2; ++n)
#pragma unroll
                        for (int i = 0; i < 4; ++i) { x1[4 * n + i] = acc[ai][0][m][n][i]; x2[4 * n + i] = acc[ai][1][m][n][i]; }
                    bf16_t* dst;
                    if (isq) dst = Q + (size_t)row * 512 + (4 * pn + wc) * 64 + d1;
                    else {
                        size_t pos;
                        if (isctx) { const int r2 = row - 32768; pos = (size_t)(r2 >> 8) * 2304 + (r2 & 255); }
                        else pos = (size_t)(row >> 11) * 2304 + 256 + (row & 2047);
                        dst = (isv ? VA : KA) + pos * 128 + (wc & 1) * 64 + d1;
                    }
                    if (!isv) {
                        float ss = 0.f;
#pragma unroll
                        for (int e = 0; e < 8; ++e) ss += x1[e] * x1[e] + x2[e] * x2[e];
                        ss += __shfl_xor(ss, 16); ss += __shfl_xor(ss, 32);
                        const float rinv = rsqrtf(ss * (1.0f / 64.0f) + 1e-6f);
#pragma unroll
                        for (int e = 0; e < 8; ++e) { x1[e] = x1[e] * rinv * w1[e]; x2[e] = x2[e] * rinv * w2[e]; }
                        if (!isctx) {
                            const int t = row & 2047, pos = (fq >> 1) ? (t & 63) : (t >> 6);
                            const f32x4* rp = (const f32x4*)(rope + (size_t)(pos * 16 + (fq & 1) * 8) * 2);
#pragma unroll
                            for (int e2 = 0; e2 < 4; ++e2) { const f32x4 cs = rp[e2];
                                { const float a = x1[2 * e2], b = x2[2 * e2]; x1[2 * e2] = a * cs[0] - b * cs[1]; x2[2 * e2] = a * cs[1] + b * cs[0]; }
                                { const float a = x1[2 * e2 + 1], b = x2[2 * e2 + 1]; x1[2 * e2 + 1] = a * cs[2] - b * cs[3]; x2[2 * e2 + 1] = a * cs[3] + b * cs[2]; } }
                        }
                    }
                    u32x4 o1, o2;
                    o1.x = cvt_pk_bf16(x1[0], x1[1]); o1.y = cvt_pk_bf16(x1[2], x1[3]); o1.z = cvt_pk_bf16(x1[4], x1[5]); o1.w = cvt_pk_bf16(x1[6], x1[7]);
                    o2.x = cvt_pk_bf16(x2[0], x2[1]); o2.y = cvt_pk_bf16(x2[2], x2[3]); o2.z = cvt_pk_bf16(x2[4], x2[5]); o2.w = cvt_pk_bf16(x2[6], x2[7]);
                    *(u32x4*)dst = o1; *(u32x4*)(dst + 16) = o2;
                }
        } else if (pn >= 5 && pn <= 8) {
            const int c0 = (pn - 5) * 128 + wc * 32 + 8 * fq;
#pragma unroll
            for (int ai = 0; ai < 2; ++ai)
#pragma unroll
                for (int m = 0; m < 4; ++m) {
                    const int row = rowb + ai * HALF + m * 16;
                    const f32x4 a0 = acc[ai][0][m][0], a1 = acc[ai][0][m][1], g0 = acc[ai][1][m][0], g1 = acc[ai][1][m][1];
                    u32x4 w;
                    w.x = cvt_pk_bf16(a0[0] * sigm_f(g0[0]), a0[1] * sigm_f(g0[1])); w.y = cvt_pk_bf16(a0[2] * sigm_f(g0[2]), a0[3] * sigm_f(g0[3]));
                    w.z = cvt_pk_bf16(a1[0] * sigm_f(g1[0]), a1[1] * sigm_f(g1[1])); w.w = cvt_pk_bf16(a1[2] * sigm_f(g1[2]), a1[3] * sigm_f(g1[3]));
                    *(u32x4*)(UG + (size_t)row * 512 + c0) = w;
                }
        } else {
            const int zc = (pn <= 4 ? (pn - 3) * 256 : 512 + (pn - 9) * 256) + wc * 32 + 8 * fq;
#pragma unroll
            for (int ai = 0; ai < 2; ++ai)
#pragma unroll
                for (int m = 0; m < 4; ++m) {
                    const int row = rowb + ai * HALF + m * 16;
#pragma unroll
                    for (int bj = 0; bj < 2; ++bj) { const f32x4 v0 = acc[ai][bj][m][0], v1 = acc[ai][bj][m][1];
                        u32x4 w; w.x = cvt_pk_bf16(silu_f(v0[0]), silu_f(v0[1])); w.y = cvt_pk_bf16(silu_f(v0[2]), silu_f(v0[3]));
                        w.z = cvt_pk_bf16(silu_f(v1[0]), silu_f(v1[1])); w.w = cvt_pk_bf16(silu_f(v1[2]), silu_f(v1[3]));
                        *(u32x4*)(Z + (size_t)row * 1024 + zc + bj * HALF) = w; }
                }
        }
    }
};

struct EpiPw {
    static constexpr bool PERM = true, AFTER_DRAIN = false;
    const bf16_t* Z; bf16_t* MIX; const float* bias;
    __device__ __forceinline__ void operator()(const f32x4 (&acc)[2][2][4][2], const Unit& u, int wr, int wc, int fr, int fq) const {
        const int rowb = u.pm * BM + wr * 64 + fr, col0 = u.pn * BM + wc * 32 + 8 * fq;
        f32x4 bv[2][2];
#pragma unroll
        for (int bj = 0; bj < 2; ++bj)
#pragma unroll
            for (int n = 0; n < 2; ++n) bv[bj][n] = *(const f32x4*)(bias + col0 + bj * HALF + 4 * n);
        u32x4 zz[2][4][2];
#pragma unroll
        for (int ai = 0; ai < 2; ++ai)
#pragma unroll
            for (int m = 0; m < 4; ++m) { const size_t off = (size_t)(rowb + ai * HALF + m * 16) * 1024 + 512 + col0;
#pragma unroll
                for (int bj = 0; bj < 2; ++bj) zz[ai][m][bj] = *(const u32x4*)(Z + off + bj * HALF); }
        asm volatile("" ::: "memory");
#pragma unroll
        for (int ai = 0; ai < 2; ++ai)
#pragma unroll
            for (int m = 0; m < 4; ++m) {
                const size_t off = (size_t)(rowb + ai * HALF + m * 16) * 1024 + 512 + col0;
#pragma unroll
                for (int bj = 0; bj < 2; ++bj) {
                    const u32x4 z = zz[ai][m][bj];
                    const f32x4 v0 = acc[ai][bj][m][0] + bv[bj][0], v1 = acc[ai][bj][m][1] + bv[bj][1];
                    u32x4 w;
                    w.x = cvt_pk_bf16(v0[0] * bf_lo(z.x), v0[1] * bf_hi(z.x)); w.y = cvt_pk_bf16(v0[2] * bf_lo(z.y), v0[3] * bf_hi(z.y));
                    w.z = cvt_pk_bf16(v1[0] * bf_lo(z.z), v1[1] * bf_hi(z.z)); w.w = cvt_pk_bf16(v1[2] * bf_lo(z.w), v1[3] * bf_hi(z.w));
                    *(u32x4*)(MIX + off + bj * HALF) = w;
                }
            }
    }
};

struct EpiOut {
    static constexpr bool PERM = false, AFTER_DRAIN = false;
    const float* x; float* out; const float* mod;
    __device__ __forceinline__ void operator()(const f32x4 (&acc)[2][2][4][2], const Unit& u, int wr, int wc, int fr, int fq) const {
        const int rowb = u.pm * BM + wr * 64 + fr, col0 = u.pn * BM + wc * 32 + 4 * fq;
        const float* gp = mod + (size_t)(u.pm >> 3) * 3072 + 2048 + col0;
        f32x4 gv[2][2];
#pragma unroll
        for (int bj = 0; bj < 2; ++bj)
#pragma unroll
            for (int n = 0; n < 2; ++n) gv[bj][n] = *(const f32x4*)(gp + bj * HALF + n * 16);
        const float* __restrict__ xr_ = x; float* __restrict__ or_ = out;
#pragma unroll
        for (int ai = 0; ai < 2; ++ai) {
            f32x4 xv[4][2][2];
#pragma unroll
            for (int m = 0; m < 4; ++m) { const size_t off = (size_t)(rowb + ai * HALF + m * 16) * 1024 + col0;
#pragma unroll
                for (int bj = 0; bj < 2; ++bj)
#pragma unroll
                    for (int n = 0; n < 2; ++n) xv[m][bj][n] = *(const f32x4*)(xr_ + off + bj * HALF + n * 16); }
            asm volatile("" ::: "memory");
#pragma unroll
            for (int m = 0; m < 4; ++m) { const size_t off = (size_t)(rowb + ai * HALF + m * 16) * 1024 + col0;
#pragma unroll
                for (int bj = 0; bj < 2; ++bj)
#pragma unroll
                    for (int n = 0; n < 2; ++n) *(f32x4*)(or_ + off + bj * HALF + n * 16) = xv[m][bj][n] + gv[bj][n] * acc[ai][bj][m][n]; }
            asm volatile("" ::: "memory");
        }
    }
};
template <class Epi, class Sched, bool ALIGN_EPI = false, bool SP2 = false>
__device__ __forceinline__ void gemm_phase(PG8_LAS unsigned char* lds, const Gemm g, const Sched& S, const Epi& E) {
    const int tid = threadIdx.x, wid = __builtin_amdgcn_readfirstlane(tid >> 6), lane = tid & 63, wr = wid >> 2, wc = wid & 3, fr = lane & 15, fq = lane >> 4;
    const int K = g.K, nt = K / BK;
    unsigned voffA[2], voffB[2];
#pragma unroll
    for (int i = 0; i < 2; ++i) { int R, C; stage_rc(tid * 16 + i * 8192, R, C); const int Rb = Epi::PERM ? ((R & ~31) + perm32(R & 31)) : R;
        voffA[i] = (unsigned)(R * K + C) * 2u; voffB[i] = (unsigned)(Rb * K + C) * 2u; }
    const size_t kstep = (size_t)(BK * 2);
    const size_t hstep = (size_t)HALF * K * 2;
    const size_t tstep = 2 * hstep;
    const unsigned ldsw = (unsigned)wid * 1024u;
    const int aoff = lds_byte(wr * 64 + fr, fq * 8), boff = lds_byte(wc * 32 + fr, fq * 8);
#define PG8_SA(b, h) (((b) * 2 + (h)) * HTB)
#define PG8_SB(b, h) ((4 + (b) * 2 + (h)) * HTB)
#define PG8_STAGE(bufoff, gbase, voff) do { _Pragma("unroll") for (int _i = 0; _i < 2; ++_i) \
        __builtin_amdgcn_global_load_lds((const unsigned*)((const char*)(gbase) + (voff)[_i]), (PG8_LAS unsigned*)(lds + (bufoff) + ldsw + _i * 8192), 16, 0, 0); } while (0)
#define PG8_LDA(dst, b, h) do { _Pragma("unroll") for (int m = 0; m < 4; ++m) _Pragma("unroll") for (int k = 0; k < 2; ++k) dst[m][k] = *(const PG8_LAS bf16x8*)(lds + PG8_SA(b, h) + aoff + m * 2048 + k * 1024); } while (0)
#define PG8_LDB(dst, b, h) do { _Pragma("unroll") for (int n = 0; n < 2; ++n) _Pragma("unroll") for (int k = 0; k < 2; ++k) dst[n][k] = *(const PG8_LAS bf16x8*)(lds + PG8_SB(b, h) + boff + n * 2048 + k * 1024); } while (0)
#define PG8_MMA(ai, bj, At, Bt) do { __builtin_amdgcn_s_setprio(1); _Pragma("unroll") for (int m = 0; m < 4; ++m) _Pragma("unroll") for (int n = 0; n < 2; ++n) _Pragma("unroll") for (int k = 0; k < 2; ++k) \
        acc[ai][bj][m][n] = __builtin_amdgcn_mfma_f32_16x16x32_bf16(Bt[n][k], At[m][k], acc[ai][bj][m][n], 0, 0, 0); __builtin_amdgcn_s_setprio(0); } while (0)
#define PG8_WAIT_V(n) asm volatile("s_waitcnt vmcnt(" #n ")" ::: "memory")
#define PG8_WAIT_L(n) asm volatile("s_waitcnt lgkmcnt(" #n ")" ::: "memory")
#define PG8_BAR __builtin_amdgcn_s_barrier()
#define PG8_SCHED __builtin_amdgcn_sched_barrier(0)
    Unit cur, nxt; int ui = 0;
    if (!S.next(0, cur)) return;
    f32x4 acc[2][2][4][2];
#pragma unroll
    for (int a = 0; a < 2; ++a)
#pragma unroll
        for (int b = 0; b < 2; ++b)
#pragma unroll
            for (int m = 0; m < 4; ++m)
#pragma unroll
                for (int n = 0; n < 2; ++n) acc[a][b][m][n] = (f32x4){0.f, 0.f, 0.f, 0.f};
    bf16x8 At[4][2], B0[2][2], B1[2][2];
    const char* cA = (const char*)g.A + (size_t)cur.pm * tstep; const char* cB = (const char*)g.Bt + (size_t)cur.pn * tstep;
    S.a_ready(cur);
    if constexpr (SP2) {
        PG8_STAGE(PG8_SB(0, 0), cB, voffB); PG8_STAGE(PG8_SB(0, 1), cB + hstep, voffB); PG8_STAGE(PG8_SA(0, 0), cA, voffA); PG8_STAGE(PG8_SA(0, 1), cA + hstep, voffA);
        if (wr == 1) PG8_BAR;
        PG8_WAIT_V(2); PG8_BAR;
        PG8_STAGE(PG8_SB(1, 0), cB + kstep, voffB); PG8_STAGE(PG8_SA(1, 0), cA + kstep, voffA); PG8_STAGE(PG8_SB(1, 1), cB + hstep + kstep, voffB);
        PG8_WAIT_V(6); PG8_BAR;
    } else {
        PG8_STAGE(PG8_SB(0, 0), cB, voffB); PG8_STAGE(PG8_SA(0, 0), cA, voffA); PG8_STAGE(PG8_SB(0, 1), cB + hstep, voffB); PG8_STAGE(PG8_SA(0, 1), cA + hstep, voffA);
        if (wr == 1) PG8_BAR;
        PG8_WAIT_V(4); PG8_BAR;
        PG8_STAGE(PG8_SB(1, 0), cB + kstep, voffB); PG8_STAGE(PG8_SA(1, 0), cA + kstep, voffA); PG8_STAGE(PG8_SB(1, 1), cB + hstep + kstep, voffB);
        PG8_WAIT_V(6); PG8_BAR;
    }
    for (;;) {
        const bool has_next = S.next(ui + 1, nxt);
        const char* nA = has_next ? (const char*)g.A + (size_t)nxt.pm * tstep : cA; const char* nB = has_next ? (const char*)g.Bt + (size_t)nxt.pn * tstep : cB;
        for (int t = 0; t < nt; t += 2) {
            const bool last = (t == nt - 2);
            const char* a1 = cA + (size_t)(t + 1) * kstep;
            const char* a2 = last ? nA : cA + (size_t)(t + 2) * kstep; const char* b2 = last ? nB : cB + (size_t)(t + 2) * kstep;
            const char* a3 = a2 + kstep; const char* b3 = b2 + kstep;
            if (last && has_next) S.a_ready(nxt);
            if constexpr (SP2) {
            PG8_LDB(B0, 0, 0); PG8_LDB(B1, 0, 1); PG8_SCHED; PG8_LDA(At, 0, 0); PG8_STAGE(PG8_SA(1, 1), a1 + hstep, voffA);
            PG8_WAIT_V(8); PG8_WAIT_L(0); PG8_BAR; PG8_MMA(0, 0, At, B0); PG8_MMA(0, 1, At, B1); PG8_BAR; PG8_SCHED;
            PG8_LDA(At, 0, 1); PG8_STAGE(PG8_SB(0, 0), b2, voffB); PG8_STAGE(PG8_SB(0, 1), b2 + hstep, voffB); PG8_STAGE(PG8_SA(0, 0), a2, voffA);
            PG8_WAIT_V(8); PG8_WAIT_L(0); PG8_BAR; PG8_MMA(1, 0, At, B0); PG8_MMA(1, 1, At, B1); PG8_BAR; PG8_SCHED;
            PG8_LDB(B0, 1, 0); PG8_LDB(B1, 1, 1); PG8_SCHED; PG8_LDA(At, 1, 0); PG8_STAGE(PG8_SA(0, 1), a2 + hstep, voffA);
            PG8_WAIT_V(8); PG8_WAIT_L(0); PG8_BAR; PG8_MMA(0, 0, At, B0); PG8_MMA(0, 1, At, B1); PG8_BAR; PG8_SCHED;
            PG8_LDA(At, 1, 1); PG8_STAGE(PG8_SB(1, 0), b3, voffB); PG8_STAGE(PG8_SB(1, 1), b3 + hstep, voffB); PG8_STAGE(PG8_SA(1, 0), a3, voffA);
            PG8_WAIT_V(8); PG8_WAIT_L(0); PG8_BAR; PG8_MMA(1, 0, At, B0); PG8_MMA(1, 1, At, B1); PG8_BAR; PG8_SCHED;
            } else {
            PG8_LDB(B0, 0, 0); PG8_SCHED; PG8_LDA(At, 0, 0); PG8_STAGE(PG8_SA(1, 1), a1 + hstep, voffA);
            PG8_WAIT_L(8); PG8_BAR; PG8_WAIT_L(0); PG8_MMA(0, 0, At, B0); PG8_BAR; PG8_SCHED;
            PG8_LDB(B1, 0, 1); PG8_STAGE(PG8_SB(0, 0), b2, voffB);
            PG8_BAR; PG8_WAIT_L(0); PG8_MMA(0, 1, At, B1); PG8_BAR;
            PG8_LDA(At, 0, 1); PG8_STAGE(PG8_SA(0, 0), a2, voffA);
            PG8_BAR; PG8_WAIT_L(0); PG8_MMA(1, 0, At, B0); PG8_BAR; PG8_SCHED;
            PG8_STAGE(PG8_SB(0, 1), b2 + hstep, voffB);
            PG8_WAIT_V(6); PG8_BAR; PG8_MMA(1, 1, At, B1); PG8_BAR;
            PG8_LDB(B0, 1, 0); PG8_SCHED; PG8_LDA(At, 1, 0); PG8_STAGE(PG8_SA(0, 1), a2 + hstep, voffA);
            PG8_WAIT_L(8); PG8_BAR; PG8_WAIT_L(0); PG8_MMA(0, 0, At, B0); PG8_BAR; PG8_SCHED;
            PG8_LDB(B1, 1, 1); PG8_STAGE(PG8_SB(1, 0), b3, voffB);
            PG8_BAR; PG8_WAIT_L(0); PG8_MMA(0, 1, At, B1); PG8_BAR;
            PG8_LDA(At, 1, 1); PG8_STAGE(PG8_SA(1, 0), a3, voffA);
            PG8_BAR; PG8_WAIT_L(0); PG8_MMA(1, 0, At, B0); PG8_BAR; PG8_SCHED;
            PG8_STAGE(PG8_SB(1, 1), b3 + hstep, voffB);
            PG8_WAIT_V(6); PG8_BAR; PG8_MMA(1, 1, At, B1); PG8_BAR;
            }
        }
        if constexpr (ALIGN_EPI) { if (wr == 0) PG8_BAR; }
        if constexpr (!Epi::AFTER_DRAIN) { E(acc, cur, wr, wc, fr, fq); S.done(cur); }
        if (!has_next) break;
#pragma unroll
        for (int a = 0; a < 2; ++a)
#pragma unroll
            for (int b = 0; b < 2; ++b)
#pragma unroll
                for (int m = 0; m < 4; ++m)
#pragma unroll
                    for (int n = 0; n < 2; ++n) acc[a][b][m][n] = (f32x4){0.f, 0.f, 0.f, 0.f};
        cur = nxt; cA = nA; cB = nB; ++ui;
        if constexpr (ALIGN_EPI) { if (wr == 1) PG8_BAR; }
    }
    PG8_WAIT_V(0);
    if constexpr (!ALIGN_EPI) { if (wr == 0) PG8_BAR; }
    PG8_BAR;
    if constexpr (Epi::AFTER_DRAIN) { E.fused(acc, cur, wr, wc, fr, fq, lds, wid, lane); S.done(cur); }
#undef PG8_SA
#undef PG8_SB
#undef PG8_STAGE
#undef PG8_LDA
#undef PG8_LDB
#undef PG8_MMA
#undef PG8_WAIT_V
#undef PG8_WAIT_L
#undef PG8_BAR
#undef PG8_SCHED
}
}
#include <hip/hip_bf16.h>
#include <cmath>
namespace attn_body {
using bf16=__hip_bfloat16;
using bf16x8=__attribute__((ext_vector_type(8)))short;
using s16x4=__attribute__((ext_vector_type(4)))short;
using f32x16=__attribute__((ext_vector_type(16)))float;
using u32x4=__attribute__((ext_vector_type(4)))unsigned;
constexpr int SEQ=2048,SKV=2304,D=64,QP=512,KP=128,OP=1024;
constexpr int NW=8,QBLK=32,QB=QBLK*NW,KVBLK=64,NQB=SEQ/QB;
constexpr int ATTN_UNIT_ROWS=QB;
__device__ __forceinline__ int crow(int r,int hi){return (r&3)+8*(r>>2)+4*hi;}
#define SBAR() __builtin_amdgcn_sched_barrier(0)
__device__ __forceinline__ void cmask(f32x16&p0,f32x16&p1,int jb,int qrel,int hi){
  const float NEG=-INFINITY; int kb=64*jb+4*hi;
  #pragma unroll
  for(int r=0;r<16;++r){int kv=kb+(r&3)+8*(r>>2); if(kv>qrel)p0[r]=NEG; if(kv+32>qrel)p1[r]=NEG;}
}

constexpr int NSLOT=3, SLOTB=8192;
constexpr int LDS_K=0, LDS_V=NSLOT*SLOTB, LDS_WS=2*NSLOT*SLOTB, LDS_OST=LDS_WS+NW*64*4, LDS_BYTES=LDS_OST+NW*4096;
constexpr float C2=0.125f*1.4426950408889634f;
__device__ __forceinline__ void glds16(const void*gsrc,unsigned lds_dst){unsigned keep;
  asm volatile("s_mov_b32 %0, m0\n\ts_mov_b32 m0, %2\n\ts_nop 0\n\tglobal_load_lds_dwordx4 %1, off\n\ts_mov_b32 m0, %0":"=&s"(keep):"v"(gsrc),"s"(lds_dst):"memory");}
__device__ __forceinline__ float max3f(float a,float b,float c){float r;asm("v_max3_f32 %0, %1, %2, %3":"=v"(r):"v"(a),"v"(b),"v"(c));return r;}
__device__ __forceinline__ float max2f(float a,float b){float r;asm("v_max_f32_e32 %0, %1, %2":"=v"(r):"v"(a),"v"(b));return r;}
__device__ __forceinline__ float fadd_s(float a,float b){float r;asm("v_add_f32_e32 %0, %1, %2":"=v"(r):"v"(a),"v"(b));return r;}
__device__ __forceinline__ float fsub_s(float a,float b){float r;asm("v_sub_f32_e32 %0, %1, %2":"=v"(r):"v"(a),"v"(b));return r;}
typedef float f32x2_t __attribute__((ext_vector_type(2))); typedef __bf16 bf16x2_t __attribute__((ext_vector_type(2)));
__device__ __forceinline__ unsigned cvtpk_s(float lo,float hi){f32x2_t v={lo,hi};bf16x2_t b=__builtin_convertvector(v,bf16x2_t);return __builtin_bit_cast(unsigned,b);}
#define WAIT_BAR(N) asm volatile("s_waitcnt vmcnt(" #N ") lgkmcnt(0)\n\ts_barrier":::"memory")

__device__ __forceinline__ void qkt(f32x16&p0,f32x16&p1,const char*Kslot,const bf16x8*qr,const f32x16&negm,int r32,int hi){
  const char*kb=Kslot+hi*1024+r32*16;
  #pragma unroll
  for(int d0=0;d0<4;++d0){
    const bf16x8 b0=*reinterpret_cast<const bf16x8*>(kb+d0*2048);
    const bf16x8 b1=*reinterpret_cast<const bf16x8*>(kb+d0*2048+512);
    if(d0==0){p0=__builtin_amdgcn_mfma_f32_32x32x16_bf16(b0,qr[0],negm,0,0,0);p1=__builtin_amdgcn_mfma_f32_32x32x16_bf16(b1,qr[0],negm,0,0,0);}
    else{p0=__builtin_amdgcn_mfma_f32_32x32x16_bf16(b0,qr[d0],p0,0,0,0);p1=__builtin_amdgcn_mfma_f32_32x32x16_bf16(b1,qr[d0],p1,0,0,0);}}
}
typedef __attribute__((address_space(3))) const char* lds_cptr;
typedef short v4i16_t __attribute__((ext_vector_type(4)));
__device__ __forceinline__ void kload8(bf16x8*kf,lds_cptr kp){
  kf[0]=*(const __attribute__((address_space(3))) bf16x8*)(kp);      kf[1]=*(const __attribute__((address_space(3))) bf16x8*)(kp+512);
  kf[2]=*(const __attribute__((address_space(3))) bf16x8*)(kp+2048); kf[3]=*(const __attribute__((address_space(3))) bf16x8*)(kp+2560);
  kf[4]=*(const __attribute__((address_space(3))) bf16x8*)(kp+4096); kf[5]=*(const __attribute__((address_space(3))) bf16x8*)(kp+4608);
  kf[6]=*(const __attribute__((address_space(3))) bf16x8*)(kp+6144); kf[7]=*(const __attribute__((address_space(3))) bf16x8*)(kp+6656);
}
__device__ __forceinline__ void kload2(bf16x8*kf,lds_cptr kp,int j){ kf[2*j]=*(const __attribute__((address_space(3))) bf16x8*)(kp+j*2048); kf[2*j+1]=*(const __attribute__((address_space(3))) bf16x8*)(kp+j*2048+512); }
__device__ __forceinline__ s16x4 vtr(lds_cptr p){ return __builtin_bit_cast(s16x4,__builtin_amdgcn_ds_read_tr16_b64_v4i16((__attribute__((address_space(3))) v4i16_t*)p)); }
__device__ __forceinline__ float rowmax(const f32x16&p0,const f32x16&p1){
  float a=max3f(p0[0],p0[1],p1[0]),b=max3f(p0[2],p0[3],p1[1]);a=max3f(a,p1[2],p1[3]);
  #pragma unroll
  for(int r=4;r<16;r+=4){a=max3f(a,p0[r],p0[r+1]);b=max3f(b,p0[r+2],p0[r+3]);a=max3f(a,p1[r],p1[r+1]);b=max3f(b,p1[r+2],p1[r+3]);}
  const float m=max2f(a,b);
  auto rr=__builtin_amdgcn_permlane32_swap(__float_as_uint(m),__float_as_uint(m),false,false);
  return max2f(__uint_as_float(rr[0]),__uint_as_float(rr[1]));
}
__device__ __forceinline__ void pv(f32x16*o,int vb,bf16x8 pa0,bf16x8 pa1,bf16x8 pa2,bf16x8 pa3){
  #pragma unroll
  for(int d0=0;d0<2;++d0){s16x4 lo[4],hi[4];
    #pragma unroll
    for(int ks=0;ks<4;++ks){
      asm volatile("ds_read_b64_tr_b16 %0,%1 offset:%c2":"=&v"(lo[ks]):"v"(vb),"i"(d0*4096+ks*1024):"memory");
      asm volatile("ds_read_b64_tr_b16 %0,%1 offset:%c2":"=&v"(hi[ks]):"v"(vb),"i"(d0*4096+ks*1024+512):"memory");}
    asm volatile("s_waitcnt lgkmcnt(0)":::"memory");SBAR();
    #define PK(k) (bf16x8){lo[k][0],lo[k][1],lo[k][2],lo[k][3],hi[k][0],hi[k][1],hi[k][2],hi[k][3]}
    o[d0]=__builtin_amdgcn_mfma_f32_32x32x16_bf16(pa0,PK(0),o[d0],0,0,0);
    o[d0]=__builtin_amdgcn_mfma_f32_32x32x16_bf16(pa1,PK(1),o[d0],0,0,0);
    o[d0]=__builtin_amdgcn_mfma_f32_32x32x16_bf16(pa2,PK(2),o[d0],0,0,0);
    o[d0]=__builtin_amdgcn_mfma_f32_32x32x16_bf16(pa3,PK(3),o[d0],0,0,0);
    #undef PK
  }
}

#ifndef ATTN_STORE16
#define ATTN_STORE16(p,v) (*(u32x4*)(p)=(v))
#endif
template<int THRL,bool FIX> __device__ __forceinline__ void attn_unit(float mfix,int b,int h,int qb,const bf16*Q,const bf16*__restrict__ K,const bf16*__restrict__ V,const bf16*__restrict__ Z,bf16*O,char*shm){
  const int tid=threadIdx.x,lane=tid&63,r32=lane&31,hi=lane>>5; const int wid=__builtin_amdgcn_readfirstlane(tid>>6);
  const long rowbase=(long)b*SEQ; const int q0=qb*QB;
  const bf16*Qw=Q+(rowbase+q0+wid*QBLK)*QP+h*D;
  const long kvbase=(long)b*SKV*KP+(h>>2)*D; const bf16*Kh=K+kvbase,*Vh=V+kvbase;
  const unsigned lds0=(unsigned)(uintptr_t)shm;
  float*wsf=(float*)(shm+LDS_WS)+wid*64;
  const bf16*ksrc=Kh+(long)lane*KP+wid*8;
  const bf16*vsrc=Vh+(long)(16*(wid&3)+(lane>>2))*KP+(wid>>2)*32+(lane&3)*8;
  const unsigned kdst=lds0+LDS_K+wid*1024, vdst=lds0+LDS_V+wid*1024;
  #define DMA_K(t,slot) glds16(ksrc+(long)(t)*KVBLK*KP,(unsigned)__builtin_amdgcn_readfirstlane(kdst+(slot)))
  #define DMA_V(t,slot) glds16(vsrc+(long)(t)*KVBLK*KP,(unsigned)__builtin_amdgcn_readfirstlane(vdst+(slot)))
  const int vb0=(int)(lds0+LDS_V)+((lane>>4)&1)*32+(lane&3)*8+(4*hi+((lane&15)>>2))*64;
  const char*Kbase=shm+LDS_K; bf16x8 kf[8];
  const lds_cptr shm3=(lds_cptr)shm; const lds_cptr kp0=shm3+LDS_K+hi*1024+r32*16; const lds_cptr vp0=shm3+LDS_V+((lane>>4)&1)*32+(lane&3)*8+(4*hi+((lane&15)>>2))*64;
  constexpr int NT=SKV/KVBLK;
  DMA_K(0,0);DMA_V(0,0);DMA_K(1,SLOTB);
  bf16x8 qr[4];
  #pragma unroll
  for(int d0=0;d0<4;++d0)qr[d0]=*reinterpret_cast<const bf16x8*>(&Qw[(long)r32*QP+d0*16+hi*8]);
  float mhat=0.f,l_reg=0.f;f32x16 o[2];o[0]=f32x16{};o[1]=f32x16{};f32x16 negm=f32x16{};
  if constexpr(FIX){ mhat=mfix; _Pragma("unroll") for(int r=0;r<16;++r)negm[r]=-mfix; }
  asm volatile("":"+v"(negm));
  const int qrel=wid*QBLK+r32;
  #define CMASK(P0,P1,t) do{}while(0)
  bool resc=false;
  #define START(P0,P1) do{ resc=false; \
    if constexpr(!FIX){ const float rm=rowmax(P0,P1); const float dl=rm; mhat=fadd_s(mhat,dl); \
      _Pragma("unroll") for(int r=0;r<16;++r){P0[r]=fsub_s(P0[r],dl);P1[r]=fsub_s(P1[r],dl);} \
      _Pragma("unroll") for(int r=0;r<16;++r)negm[r]=-mhat; asm volatile("":"+v"(negm)); } \
    _Pragma("unroll") for(int r=0;r<16;++r)P0[r]=__builtin_amdgcn_exp2f(P0[r]); }while(0)
  #define RESC() do{ if(resc){ asm volatile("s_waitcnt lgkmcnt(0)":::"memory"); \
      _Pragma("unroll") for(int d_=0;d_<2;++d_) _Pragma("unroll") for(int r=0;r<16;++r)o[d_][r]*=wsf[crow(r,hi)]; } }while(0)
  f32x16 pA0,pA1,pB0,pB1;
  int sl_prev=0,sl_cur=0,sl_next=SLOTB;
  #define ROT() do{sl_prev=sl_cur;sl_cur=sl_next;sl_next=(sl_next==(NSLOT-1)*SLOTB)?0:sl_next+SLOTB;}while(0)
  DMA_K(2,2*SLOTB);
  WAIT_BAR(3);
  qkt(pA0,pA1,Kbase,qr,negm,r32,hi);asm volatile("s_nop 15\n\ts_nop 7":"+v"(pA0),"+v"(pA1));CMASK(pA0,pA1,0);
  START(pA0,pA1);
  _Pragma("unroll") for(int r=0;r<16;++r)pA1[r]=__builtin_amdgcn_exp2f(pA1[r]);
  WAIT_BAR(0);
  DMA_K(3,0);DMA_V(1,SLOTB);
  ROT();
  kload8(kf,kp0+sl_cur);
  WAIT_BAR(2);
  s16x4 vlo[8],vhi[8]; u32x4 pw0,pw1,pw2,pw3;
  #define PKW(P,B) cvtpk_s(P[B],P[B+1])
  #define PAF(k) __builtin_bit_cast(bf16x8,pw##k)
  #define VFR(i) (bf16x8){vlo[i][0],vlo[i][1],vlo[i][2],vlo[i][3],vhi[i][0],vhi[i][1],vhi[i][2],vhi[i][3]}
  #define PIN(x) asm volatile("":"+v"(x))
  #define MX3(a,b,c) __builtin_fmaxf(__builtin_fmaxf((a),(b)),(c))
  #define GAPA(MF,A0,A1,A2,A3,W0,W1,PW) do{ MF; sacc+=A0; sacc+=A1; sacc+=A2; sacc+=A3; PIN(sacc); W0; W1; PIN(PW); SBAR(); }while(0)
  #define EX(v) __builtin_amdgcn_exp2f(v)
  #define GAPB(MF,X,B) do{ MF; X[B]=EX(X[B]); X[B+1]=EX(X[B+1]); X[B+2]=EX(X[B+2]); X[B+3]=EX(X[B+3]); PIN(X); SBAR(); }while(0)
  #define VRD(i) do{ vlo[i]=vtr(vp_+(((i)>>2)*4096+((i)&3)*1024)); vhi[i]=vtr(vp_+(((i)>>2)*4096+((i)&3)*1024+512)); }while(0)
  #define KRD(G,j) do{ if(G){ kload2(kf,kp0+sl_next,j); SBAR(); } }while(0)
  #define STEP(C0,C1,P0,P1,t,GK,GV,GL) do{ SBAR(); \
    const lds_cptr vp_=vp0+sl_prev; \
    VRD(0); SBAR(); float sacc=(P0[0]+P0[1]); \
    GAPA(C0=__builtin_amdgcn_mfma_f32_32x32x16_bf16(kf[0],qr[0],negm,0,0,0), P0[2],P0[3],P0[4],P0[5],     pw0[0]=PKW(P0,0), pw0[1]=PKW(P0,2), pw0); \
    VRD(4); SBAR(); GAPA(C1=__builtin_amdgcn_mfma_f32_32x32x16_bf16(kf[1],qr[0],negm,0,0,0), P0[6],P0[7],P0[8],P0[9],     pw0[2]=PKW(P0,4), pw0[3]=PKW(P0,6), pw0); \
    VRD(1); SBAR(); GAPA(C0=__builtin_amdgcn_mfma_f32_32x32x16_bf16(kf[2],qr[1],C0,0,0,0),   P0[10],P0[11],P0[12],P0[13], pw1[0]=PKW(P0,8), pw1[1]=PKW(P0,10), pw1); \
    VRD(5); SBAR(); GAPA(C1=__builtin_amdgcn_mfma_f32_32x32x16_bf16(kf[3],qr[1],C1,0,0,0),   P0[14],P0[15],P1[0],P1[1],   pw1[2]=PKW(P0,12),pw1[3]=PKW(P0,14), pw1); \
    VRD(2); SBAR(); GAPA(C0=__builtin_amdgcn_mfma_f32_32x32x16_bf16(kf[4],qr[2],C0,0,0,0),   P1[2],P1[3],P1[4],P1[5],     pw2[0]=PKW(P1,0), pw2[1]=PKW(P1,2), pw2); \
    VRD(6); SBAR(); GAPA(C1=__builtin_amdgcn_mfma_f32_32x32x16_bf16(kf[5],qr[2],C1,0,0,0),   P1[6],P1[7],P1[8],P1[9],     pw2[2]=PKW(P1,4), pw2[3]=PKW(P1,6), pw2); \
    VRD(3); SBAR(); GAPA(C0=__builtin_amdgcn_mfma_f32_32x32x16_bf16(kf[6],qr[3],C0,0,0,0),   P1[10],P1[11],P1[12],P1[13], pw3[0]=PKW(P1,8), pw3[1]=PKW(P1,10), pw3); \
    VRD(7); SBAR(); GAPA(C1=__builtin_amdgcn_mfma_f32_32x32x16_bf16(kf[7],qr[3],C1,0,0,0),   P1[14],P1[15],0.f,0.f,       pw3[2]=PKW(P1,12),pw3[3]=PKW(P1,14), pw3); \
    l_reg+=sacc; \
    if(GK){DMA_K((t)+3,sl_cur);} if(GV){DMA_V((t)+1,sl_next);} \
    CMASK(C0,C1,t); \
    if constexpr(!FIX){ float a=MX3(C0[0],C0[1],C1[0]),b=MX3(C0[2],C0[3],C1[1]); a=MX3(a,C1[2],C1[3]); \
      _Pragma("unroll") for(int r=4;r<16;r+=4){a=MX3(a,C0[r],C0[r+1]);b=MX3(b,C0[r+2],C0[r+3]);a=MX3(a,C1[r],C1[r+1]);b=MX3(b,C1[r+2],C1[r+3]);} \
      float rm=__builtin_fmaxf(a,b); { auto rr=__builtin_amdgcn_permlane32_swap(__float_as_uint(rm),__float_as_uint(rm),false,false); rm=__builtin_fmaxf(__uint_as_float(rr[0]),__uint_as_float(rr[1])); } \
      resc=false; \
      if(__builtin_expect(__any(rm>(float)THRL),0)){ const float dl=__builtin_fmaxf(rm,0.f); mhat+=dl; \
        _Pragma("unroll") for(int r=0;r<16;++r){C0[r]-=dl;C1[r]-=dl;} \
        _Pragma("unroll") for(int r=0;r<16;++r)negm[r]=-mhat; asm volatile("":"+v"(negm)); \
        const float f=__builtin_amdgcn_exp2f(-dl); l_reg*=f; if(hi==0)wsf[r32]=f; resc=true; } } \
    SBAR(); \
    GAPB(o[0]=__builtin_amdgcn_mfma_f32_32x32x16_bf16(PAF(0),VFR(0),o[0],0,0,0), C0,0); \
    GAPB(o[1]=__builtin_amdgcn_mfma_f32_32x32x16_bf16(PAF(0),VFR(4),o[1],0,0,0), C0,4); \
    KRD(GL,0); GAPB(o[0]=__builtin_amdgcn_mfma_f32_32x32x16_bf16(PAF(1),VFR(1),o[0],0,0,0), C0,8); \
    KRD(GL,1); GAPB(o[1]=__builtin_amdgcn_mfma_f32_32x32x16_bf16(PAF(1),VFR(5),o[1],0,0,0), C0,12); \
    KRD(GL,2); GAPB(o[0]=__builtin_amdgcn_mfma_f32_32x32x16_bf16(PAF(2),VFR(2),o[0],0,0,0), C1,0); \
    KRD(GL,3); GAPB(o[1]=__builtin_amdgcn_mfma_f32_32x32x16_bf16(PAF(2),VFR(6),o[1],0,0,0), C1,4); \
    GAPB(o[0]=__builtin_amdgcn_mfma_f32_32x32x16_bf16(PAF(3),VFR(3),o[0],0,0,0), C1,8); \
    GAPB(o[1]=__builtin_amdgcn_mfma_f32_32x32x16_bf16(PAF(3),VFR(7),o[1],0,0,0), C1,12); \
    }while(0)
  int t=1;
  #undef CMASK
  #define CMASK(P0,P1,t) do{}while(0)
  for(;t+5<NT;t+=2){
    STEP(pB0,pB1,pA0,pA1,t,true,true,true);     WAIT_BAR(2); RESC(); ROT();
    STEP(pA0,pA1,pB0,pB1,t+1,true,true,true);   WAIT_BAR(2); RESC(); ROT();
  }
  #undef CMASK
  #define CMASK(P0,P1,t) do{}while(0)
  #define ENDW(tt) do{ if((tt)+3<NT){WAIT_BAR(2);} else if((tt)+2<NT){WAIT_BAR(1);} else {WAIT_BAR(0);} }while(0)
  for(;t+1<NT;t+=2){
    STEP(pB0,pB1,pA0,pA1,t,(t+3<NT),(t+1<NT),(t+1<NT));       ENDW(t);   RESC(); ROT();
    STEP(pA0,pA1,pB0,pB1,t+1,(t+4<NT),(t+2<NT),(t+2<NT));     ENDW(t+1); RESC(); ROT();
  }
  STEP(pB0,pB1,pA0,pA1,NT-1,false,false,false); RESC();
  { float sacc=pB0[0]+pB0[1]; _Pragma("unroll") for(int r=2;r<16;++r)sacc+=pB0[r]; _Pragma("unroll") for(int r=0;r<16;++r)sacc+=pB1[r]; l_reg+=sacc;
    pw0=(u32x4){PKW(pB0,0),PKW(pB0,2),PKW(pB0,4),PKW(pB0,6)};pw1=(u32x4){PKW(pB0,8),PKW(pB0,10),PKW(pB0,12),PKW(pB0,14)};pw2=(u32x4){PKW(pB1,0),PKW(pB1,2),PKW(pB1,4),PKW(pB1,6)};pw3=(u32x4){PKW(pB1,8),PKW(pB1,10),PKW(pB1,12),PKW(pB1,14)};
    SBAR(); pv(o,vb0+sl_cur,PAF(0),PAF(1),PAF(2),PAF(3)); }
  #undef PKW
  #undef PAF
  #undef VFR
  #undef PIN
  #undef MX3
  #undef GAPA
  #undef GAPB
  #undef EX
  #undef VRD
  #undef KRD
  #undef STEP
  #undef ENDW
  {auto rr=__builtin_amdgcn_permlane32_swap(__float_as_uint(l_reg),__float_as_uint(l_reg),false,false);l_reg=__uint_as_float(rr[0])+__uint_as_float(rr[1]);}
  if(hi==0)wsf[32+r32]=l_reg;asm volatile("s_waitcnt lgkmcnt(0)":::"memory");
  float rli[16];
  #pragma unroll
  for(int r=0;r<16;++r)rli[r]=__builtin_amdgcn_rcpf(wsf[32+crow(r,hi)]);
  const long orow0=(rowbase+q0+wid*QBLK)*OP+h*D; bf16*Ow=O+orow0; const bf16*Zw=Z+orow0;
  { bf16*stg=(bf16*)(shm+LDS_OST)+wid*2048;
    #pragma unroll
    for(int r=0;r<16;++r){const int orow=crow(r,hi);
      #pragma unroll
      for(int d0=0;d0<2;++d0)stg[orow*64+d0*32+r32]=__float2bfloat16(o[d0][r]*rli[r]);}
    asm volatile("s_waitcnt lgkmcnt(0)":::"memory");
    #pragma unroll
    for(int i=0;i<4;++i){const int row=i*8+(lane>>3),ch=lane&7; const u32x4 v=*(const u32x4*)(stg+row*64+ch*8); const u32x4 z=*(const u32x4*)(Zw+(long)row*OP+ch*8);
      u32x4 w; w.x=cvtpk_s(__uint_as_float(v.x<<16)*__uint_as_float(z.x<<16),__uint_as_float(v.x&0xffff0000u)*__uint_as_float(z.x&0xffff0000u));
      w.y=cvtpk_s(__uint_as_float(v.y<<16)*__uint_as_float(z.y<<16),__uint_as_float(v.y&0xffff0000u)*__uint_as_float(z.y&0xffff0000u));
      w.z=cvtpk_s(__uint_as_float(v.z<<16)*__uint_as_float(z.z<<16),__uint_as_float(v.z&0xffff0000u)*__uint_as_float(z.z&0xffff0000u));
      w.w=cvtpk_s(__uint_as_float(v.w<<16)*__uint_as_float(z.w<<16),__uint_as_float(v.w&0xffff0000u)*__uint_as_float(z.w&0xffff0000u));
      ATTN_STORE16(Ow+(long)row*OP+ch*8,w);} }
  asm volatile("s_waitcnt lgkmcnt(0)\n\ts_barrier":::"memory");
  #undef DMA_K
  #undef DMA_V
  #undef CMASK
  #undef START
  #undef RESC
  #undef ROT
}
constexpr int ATTN_LDS_BYTES=LDS_BYTES;
struct AttnTensors { const bf16* Q; const bf16* K; const bf16* V; const bf16* Z; bf16* O; };
template<int THRL,bool FIX> __device__ __forceinline__ void attn_phase(char*lds,const AttnTensors&T,int vcu,int G,float mfix){
  for(int u=vcu;u<1024;u+=G){ const int un=(G==256)?((vcu<<2)+((u-vcu)>>8)):u;
    attn_unit<THRL,FIX>(mfix,un>>6,(un>>3)&7,un&7,T.Q,T.K,T.V,T.Z,T.O,lds); }
}
#undef SBAR
#undef WAIT_BAR
}
constexpr int NWAVES = 8;
constexpr int BATCH = 16, SEQ = 2048, DM = 1024, CTX = 256, DIN = 2816, DCONV = 512;
constexpr int M = BATCH * SEQ;
constexpr int MC = BATCH * CTX;
constexpr size_t MiB = 1u << 20;
constexpr size_t WS_MOD = 0, WS_ROPE = 1 * MiB, WS_WIN = 2 * MiB, WS_WPW = 8 * MiB, WS_WOUT = 9 * MiB, WS_U = 16 * MiB, WS_Q = 88 * MiB, WS_KA = 120 * MiB, WS_VA = 130 * MiB,
                 WS_CTL = 12 * MiB, WS_Z = 140 * MiB, WS_UG = 204 * MiB, WS_Y = 236 * MiB, WS_MIX = 268 * MiB, WS_END = 332 * MiB;
constexpr size_t CTL_ZERO_BYTES = 16384;
constexpr int RING_BYTES = 131072, MISC_OFF = RING_BYTES + 320, LDS_BYTES = 147456;
#define LAS __attribute__((address_space(3)))
typedef unsigned short bf16;
typedef unsigned v4u __attribute__((ext_vector_type(4)));
typedef float f32x4 __attribute__((ext_vector_type(4)));
typedef float f32x2 __attribute__((ext_vector_type(2)));
#define LDS_WAIT() asm volatile("s_waitcnt lgkmcnt(0)" ::: "memory")
__device__ __forceinline__ unsigned pk2(float lo, float hi) { return pg8::cvt_pk_bf16(lo, hi); }
__device__ __forceinline__ float wave_sum(float v) {
#pragma unroll
    for (int o = 1; o < 64; o <<= 1) v += __shfl_xor(v, o);
    return v;
}
#define GAS __attribute__((address_space(1)))
#define RLX_AGENT __ATOMIC_RELAXED, __HIP_MEMORY_SCOPE_AGENT
#define XB_TMO      128
#define XB_XCNT(j)  (256  + 64 * (j))
#define XB_XSUB(j)  (1280 + 64 * (j))
#define XB_XGEN(j)  (2304 + 64 * (j))
#define XB_TOP      3328
#define XB_TOPGEN   3392
#define XCD_BAR_WORDS 3456
#define XB_SPIN_CAP (1u << 18)

__device__ __forceinline__ unsigned xb_ld(unsigned* p)              { return __hip_atomic_load(p, __ATOMIC_RELAXED, __HIP_MEMORY_SCOPE_AGENT); }
__device__ __forceinline__ unsigned xb_add(unsigned* p, unsigned v) { return __hip_atomic_fetch_add(p, v, __ATOMIC_RELAXED, __HIP_MEMORY_SCOPE_AGENT); }
__device__ __forceinline__ unsigned xb_xcc_id() { return (unsigned)__builtin_amdgcn_s_getreg((3 << 11) | 20) & 0xFu; }
#define XB_SPIN(cond, bar) do { unsigned _sp = 0; while (cond) { __builtin_amdgcn_s_sleep(1); \
    if ((++_sp & 255u) == 0u) { if (xb_ld(&(bar)[XB_TMO])) break; if (_sp > XB_SPIN_CAP) { atomicAdd(&(bar)[XB_TMO], 1u); break; } } } } while (0)

struct XcdBarrier {
    unsigned* bar; unsigned x;
    volatile LAS unsigned* st;
};

__device__ __forceinline__ XcdBarrier xcd_barrier_post(unsigned* bar, volatile LAS unsigned* st) {
    XcdBarrier b; b.bar = bar; b.x = xb_xcc_id(); b.st = st;
    if (threadIdx.x == 0) (void)xb_add(&bar[XB_XCNT(b.x)], 1u);
    return b;
}
__device__ __forceinline__ void xcd_barrier_complete(unsigned* bar, unsigned x, unsigned& nloc, unsigned& nx) {
    const unsigned G = gridDim.x * gridDim.y * gridDim.z;
    unsigned sum, cnt, mine, sp = 0u;
    for (;;) {
        sum = 0u; cnt = 0u; mine = 0u;
#pragma unroll
        for (unsigned j = 0; j < 16; ++j) { const unsigned c = xb_ld(&bar[XB_XCNT(j)]); sum += c; cnt += (c > 0u) ? 1u : 0u; mine = (j == x) ? c : mine; }
        if (sum == G) break;
        __builtin_amdgcn_s_sleep(1);
        if ((++sp & 255u) == 0u) { if (xb_ld(&bar[XB_TMO])) break; if (sp > XB_SPIN_CAP) { atomicAdd(&bar[XB_TMO], 1u); break; } }
    }
    nloc = mine > 0u ? mine : 1u; nx = cnt > 0u ? cnt : 1u;
}

__device__ __forceinline__ void xcd_barrier(const XcdBarrier& b) {
    asm volatile("s_waitcnt vmcnt(0)" ::: "memory");
    __syncthreads();
    if (threadIdx.x == 0) {
        unsigned* bar = b.bar;
        __builtin_amdgcn_s_waitcnt(0);
        unsigned nloc = b.st[0], nx = b.st[1];
        if (nloc == 0u) { xcd_barrier_complete(bar, b.x, nloc, nx); b.st[0] = nloc; b.st[1] = nx; }
        const unsigned old = xb_add(&bar[XB_XSUB(b.x)], 1u);
        const unsigned gen = old / nloc;
        if (old + 1u == (gen + 1u) * nloc) {
            __builtin_amdgcn_fence(__ATOMIC_RELEASE, "agent");
            asm volatile("s_waitcnt vmcnt(0)" ::: "memory");
            const unsigned og = xb_add(&bar[XB_TOP], 1u);
            const unsigned tg = og / nx;
            if (og + 1u == (tg + 1u) * nx) xb_add(&bar[XB_TOPGEN], 1u);
            else XB_SPIN(xb_ld(&bar[XB_TOPGEN]) == tg, bar);
            __builtin_amdgcn_fence(__ATOMIC_ACQUIRE, "agent");
            xb_add(&bar[XB_XGEN(b.x)], 1u);
            asm volatile("s_waitcnt vmcnt(0)" ::: "memory");
        } else {
            XB_SPIN(xb_ld(&bar[XB_XGEN(b.x)]) == gen, bar);
            __builtin_amdgcn_fence(__ATOMIC_ACQUIRE, "agent");
            asm volatile("s_waitcnt vmcnt(0)" ::: "memory");
        }
    }
    __syncthreads();
}
__device__ __forceinline__ int lmap_in(int P) {
    if (P < 768) { const int tile = P >> 8, p = P & 255, bj = p >> 7, wc = (p >> 5) & 3, j = p & 31; return tile * 256 + wc * 64 + ((j < 16) ? j : j + 16) + 16 * bj; }
    if (P >= 1280 && P < 2304) { const int q = P - 1280, T = q >> 8, p = q & 255; return (p < 128) ? (1280 + 128 * T + p) : (1792 + 128 * T + (p - 128)); }
    return P;
}
template <bool MAP> __device__ __forceinline__ void p0_transpose_item(const float* W, int K, int N, bf16* WT, LAS float* scr, int item, int lane) {
    const int nblk = N / 32, kb = item / nblk, nb = item % nblk, k0 = 64 * kb, n0 = 32 * nb;
    const int ncol = MAP ? lmap_in(n0 + (lane & 31)) : (n0 + (lane & 31));
#pragma unroll 8
    for (int i = 0; i < 32; ++i) { const int kk = 2 * i + (lane >> 5); scr[kk * 33 + (lane & 31)] = W[(size_t)(k0 + kk) * N + ncol]; }
    LDS_WAIT(); asm volatile("" ::: "memory");
    const int c = lane & 7;
#pragma unroll
    for (int j = 0; j < 4; ++j) { const int n = (lane >> 3) + 8 * j; const LAS float* s = scr + (8 * c) * 33 + n;
        v4u o; o.x = pk2(s[0 * 33], s[1 * 33]); o.y = pk2(s[2 * 33], s[3 * 33]); o.z = pk2(s[4 * 33], s[5 * 33]); o.w = pk2(s[6 * 33], s[7 * 33]);
        *(v4u*)(WT + (size_t)(n0 + n) * K + k0 + 8 * c) = o; }
    LDS_WAIT(); asm volatile("" ::: "memory");
}
__device__ __forceinline__ void mod_item(LAS unsigned char* lds, const float* c, const float* cctx, const float* wmod, const float* bmod, float* MOD, int nc, int tid) {
    LAS float* sc = (LAS float*)lds;
    LAS float* part = sc + 17 * 1024;
    const int w = tid >> 6, lane = tid & 63, col = lane & 15, kq = lane >> 4, n = nc * 16 + col, kbase = 128 * w + 32 * kq;
    float wv[32];
#pragma unroll
    for (int i = 0; i < 32; ++i) wv[i] = wmod[(size_t)(kbase + i) * 3072 + n];
    for (int idx = tid; idx < 17 * 1024; idx += 512) { const int r = idx >> 10, k = idx & 1023; const float v = (r < 16) ? c[r * 1024 + k] : cctx[k]; sc[idx] = pg8::silu_f(v); }
    __syncthreads();
    float acc[17];
#pragma unroll
    for (int r = 0; r < 17; ++r) acc[r] = 0.f;
#pragma unroll
    for (int i = 0; i < 32; ++i) {
#pragma unroll
        for (int r = 0; r < 17; ++r) acc[r] += sc[r * 1024 + kbase + i] * wv[i]; }
#pragma unroll
    for (int r = 0; r < 17; ++r) part[((w * 4 + kq) * 17 + r) * 16 + col] = acc[r];
    __syncthreads();
    for (int idx = tid; idx < 17 * 16; idx += 512) { const int r = idx >> 4, l = idx & 15; float sum = bmod[nc * 16 + l];
#pragma unroll
        for (int p = 0; p < 32; ++p) sum += part[(p * 17 + r) * 16 + l];
        MOD[(size_t)r * 3072 + nc * 16 + l] = sum; }
    __syncthreads();
}
__device__ __forceinline__ void p1_rows(const float* x, const float* ctx, const float* normw, const float* MOD, bf16* U, int gw, int NGW, int lane) {
    for (int ch = gw; ch < (M + MC) / 4; ch += NGW) {
        const int row0 = 4 * ch; const bool isc = row0 >= M; const int b = isc ? 16 : (row0 >> 11);
        const float* src = isc ? ctx + (size_t)(row0 - M) * DM : x + (size_t)row0 * DM;
        const float* mp = MOD + (size_t)b * 3072;
        f32x4 g[4], sh[4];
#pragma unroll
        for (int j = 0; j < 4; ++j) { const int col = 4 * lane + 256 * j; const f32x4 nw = *(const f32x4*)(normw + col), scl = *(const f32x4*)(mp + 1024 + col); sh[j] = *(const f32x4*)(mp + col); g[j] = nw * (1.0f + scl); }
        f32x4 vv[4][4];
#pragma unroll
        for (int rr = 0; rr < 4; ++rr) { const f32x4* xr = (const f32x4*)(src + (size_t)rr * DM) + lane;
#pragma unroll
            for (int j = 0; j < 4; ++j) vv[rr][j] = xr[64 * j]; }
        asm volatile("" ::: "memory");
#pragma unroll
        for (int rr = 0; rr < 4; ++rr) {
            f32x4 v[4]; float s = 0.f;
#pragma unroll
            for (int j = 0; j < 4; ++j) { v[j] = vv[rr][j]; s += (v[j].x * v[j].x + v[j].y * v[j].y) + (v[j].z * v[j].z + v[j].w * v[j].w); }
            const float rinv = rsqrtf(wave_sum(s) * (1.0f / DM) + 1e-6f);
            unsigned long long* o8 = (unsigned long long*)(U + (size_t)(row0 + rr) * DM) + lane;
#pragma unroll
            for (int j = 0; j < 4; ++j) { const f32x4 o = v[j] * rinv * g[j] + sh[j];
                o8[64 * j] = (unsigned long long)pk2(o.x, o.y) | ((unsigned long long)pk2(o.z, o.w) << 32); }
        }
    }
}
__device__ __forceinline__ void conv_phase(LAS unsigned char* lds, const bf16* UG, const float* cw, const float* cb, const float* lnw, const float* lnb, bf16* Y, int vcu, int G, int tid) {
    LAS float* tile = (LAS float*)lds;
    const int cp = tid & 255, th = tid >> 8, wv = tid >> 6, lane = tid & 63;
    f32x2 w[31];
#pragma unroll
    for (int j = 0; j < 31; ++j) w[j] = *(const f32x2*)(cw + j * 512 + 2 * cp);
    const f32x2 bias = *(const f32x2*)(cb + 2 * cp);
    for (int item = vcu; item < M / 32; item += G) {
        const int row0 = item * 32 + th * 16, t0 = row0 & 2047;
        const unsigned* ub = (const unsigned*)(UG + (size_t)(row0 - t0) * 512 + 2 * cp);
        unsigned xr[46];
#pragma unroll
        for (int r = 0; r < 46; ++r) { const int tin = t0 - 15 + r, tc = tin < 0 ? 0 : (tin > 2047 ? 2047 : tin); xr[r] = ub[(size_t)tc * 256]; }
        f32x2 acc[16];
#pragma unroll
        for (int i = 0; i < 16; ++i) acc[i] = (f32x2){0.f, 0.f};
#pragma unroll
        for (int r = 0; r < 46; ++r) {
            const int tin = t0 - 15 + r; const bool ok = (tin >= 0) && (tin < 2048);
            const f32x2 xv = (f32x2){ok ? pg8::bf_lo(xr[r]) : 0.f, ok ? pg8::bf_hi(xr[r]) : 0.f};
#pragma unroll
            for (int i = 0; i < 16; ++i) { const int j = r - i; if (j >= 0 && j <= 30) acc[i] += xv * w[j]; }
        }
#pragma unroll
        for (int i = 0; i < 16; ++i) *(LAS f32x2*)(tile + (th * 16 + i) * 512 + 2 * cp) = acc[i] + bias;
        __syncthreads();
        const f32x4 lw0 = *(const f32x4*)(lnw + 8 * lane), lw1 = *(const f32x4*)(lnw + 8 * lane + 4), lb0 = *(const f32x4*)(lnb + 8 * lane), lb1 = *(const f32x4*)(lnb + 8 * lane + 4);
#pragma unroll
        for (int rr = 0; rr < 4; ++rr) {
            const int row = 4 * wv + rr;
            const f32x4 a = *(const LAS f32x4*)(tile + row * 512 + 8 * lane), b = *(const LAS f32x4*)(tile + row * 512 + 8 * lane + 4);
            const float mean = wave_sum((a.x + a.y) + (a.z + a.w) + (b.x + b.y) + (b.z + b.w)) * (1.0f / 512.0f);
            const f32x4 da = a - mean, db = b - mean;
            const float var = wave_sum((da.x * da.x + da.y * da.y) + (da.z * da.z + da.w * da.w) + (db.x * db.x + db.y * db.y) + (db.z * db.z + db.w * db.w)) * (1.0f / 512.0f);
            const float rstd = rsqrtf(var + 1e-6f);
            const f32x4 ya = da * rstd * lw0 + lb0, yb = db * rstd * lw1 + lb1;
            v4u o; o.x = pk2(pg8::silu_f(ya.x), pg8::silu_f(ya.y)); o.y = pk2(pg8::silu_f(ya.z), pg8::silu_f(ya.w)); o.z = pk2(pg8::silu_f(yb.x), pg8::silu_f(yb.y)); o.w = pk2(pg8::silu_f(yb.z), pg8::silu_f(yb.w));
            *(v4u*)(Y + (size_t)(item * 32 + row) * 512 + 8 * lane) = o;
        }
        __syncthreads();
    }
}

#ifndef MK_N_LAUNCHES
#define MK_N_LAUNCHES 1
#endif
constexpr int N_PHASES = 6;
struct Args { const float* in[17]; float* out; unsigned char* ws; int ph_lo, ph_hi; };
__global__ void __launch_bounds__(NWAVES * 64, 2) hybrid_fwd(Args args) {
    extern __shared__ __attribute__((aligned(16))) unsigned char lds[];
    LAS unsigned char* ldsl = (LAS unsigned char*)lds;
    const int tid = threadIdx.x, lane = tid & 63, wave = __builtin_amdgcn_readfirstlane(tid >> 6);
    const int G = gridDim.x, bx = blockIdx.x, vcu = (G % 8 == 0) ? (bx % 8) * (G / 8) + bx / 8 : bx;
    const int gw = vcu * NWAVES + wave, NGW = G * NWAVES;
    unsigned char* ws = args.ws;
    const float *x = args.in[0], *cvec = args.in[1], *ctx = args.in[2], *cctx = args.in[3], *wmod = args.in[4], *bmod = args.in[5], *normw = args.in[6], *win = args.in[7],
                *qnw = args.in[8], *knw = args.in[9], *convw = args.in[10], *convb = args.in[11], *lnw = args.in[12], *lnb = args.in[13], *wpw = args.in[14], *bpw = args.in[15], *wout = args.in[16];
    float* MOD = (float*)(ws + WS_MOD); float* ROPE = (float*)(ws + WS_ROPE);
    bf16 *WIN_T = (bf16*)(ws + WS_WIN), *WPW_T = (bf16*)(ws + WS_WPW), *WOUT_T = (bf16*)(ws + WS_WOUT), *U = (bf16*)(ws + WS_U), *Q = (bf16*)(ws + WS_Q), *KA = (bf16*)(ws + WS_KA), *VA = (bf16*)(ws + WS_VA),
         *Z = (bf16*)(ws + WS_Z), *UG = (bf16*)(ws + WS_UG), *Y = (bf16*)(ws + WS_Y), *MIX = (bf16*)(ws + WS_MIX);
    const int lo = args.ph_lo, hi = args.ph_hi;
#define IN(k) (lo <= (k) && (k) < hi)
    for (int u = tid; u < (LDS_BYTES - RING_BYTES) / 4; u += NWAVES * 64) ((LAS unsigned*)(ldsl + RING_BYTES))[u] = 0u;
    __syncthreads();
    XcdBarrier bar; bar.bar = (unsigned*)(ws + WS_CTL); bar.x = 0; bar.st = nullptr;
    if (hi - lo > 1) bar = xcd_barrier_post((unsigned*)(ws + WS_CTL), (volatile LAS unsigned*)(ldsl + MISC_OFF) + 8);
    if (lo > 99) cooperative_groups::this_grid().sync();
#define SEAM(k) do { if (IN(k) && IN((k) + 1)) xcd_barrier(bar); } while (0)
#ifndef REPMASK
#define REPMASK 0
#endif
#define REPS(k) for (int rep_ = 0; rep_ < 1 + ((REPMASK >> (k)) & 1); ++rep_)

    if (IN(0)) REPS(0) {
        LAS float* scr = (LAS float*)(ldsl + wave * 16384);
        constexpr int I_IN = (DM / 64) * (DIN / 32), I_PW = (DCONV / 64) * (DCONV / 32), I_OUT = (DM / 64) * (DM / 32);
        for (int it = gw; it < I_IN + I_PW + I_OUT; it += NGW) {
            int r = it;
            if (r < I_IN) { p0_transpose_item<true>(win, DM, DIN, WIN_T, scr, r, lane); continue; } r -= I_IN;
            if (r < I_PW) { p0_transpose_item<false>(wpw, DCONV, DCONV, WPW_T, scr, r, lane); continue; } r -= I_PW;
            p0_transpose_item<false>(wout, DM, DM, WOUT_T, scr, r, lane);
        }
        { const int gt = bx * 512 + tid;
          if (gt < 1024) { const int pos = gt >> 4, f = gt & 15; const float freq = powf(10000.0f, -(float)f * (1.0f / 16.0f)); const float ang = (float)pos * freq;
              ROPE[2 * gt] = cosf(ang); ROPE[2 * gt + 1] = sinf(ang); } }
        __syncthreads();
        for (int nc = bx; nc < 192; nc += G) mod_item(ldsl, cvec, cctx, wmod, bmod, MOD, nc, tid);
    }
    SEAM(0);
    if (IN(1)) REPS(1) p1_rows(x, ctx, normw, MOD, U, gw, NGW, lane);
    SEAM(1);
    if (IN(2)) REPS(2) {
        pg8::Gemm g{U, WIN_T, M + MC, DIN, DM}; pg8::OrderIn S; S.init(G, bx);
        pg8::EpiIn E{Q, KA, VA, Z, UG, ROPE, qnw, knw};
        pg8::gemm_phase<pg8::EpiIn, pg8::OrderIn, true, true>(ldsl, g, S, E);
    }
    SEAM(2);
    if (IN(3)) REPS(3) conv_phase(ldsl, UG, convw, convb, lnw, lnb, Y, vcu, G, tid);
    SEAM(3);
    if (IN(4)) REPS(4) {
        const attn_body::AttnTensors AT{(const attn_body::bf16*)Q, (const attn_body::bf16*)KA, (const attn_body::bf16*)VA, (const attn_body::bf16*)Z, (attn_body::bf16*)MIX};
        float mq = 0.f, mk = 0.f;
        for (int d = 0; d < 64; ++d) { mq = fmaxf(mq, fabsf(qnw[d])); mk = fmaxf(mk, fabsf(knw[d])); }
        const float mfix = 1.02f * 64.0f * pg8::QC2 * mq * mk;
        if (mfix <= 60.0f) attn_body::attn_phase<8, true>((char*)lds, AT, vcu, G, mfix);
        else               attn_body::attn_phase<8, false>((char*)lds, AT, vcu, G, 0.f);
        pg8::Gemm g{Y, WPW_T, M, DCONV, DCONV}; pg8::StaticOrder S; S.init(M, DCONV, G, bx);
        pg8::EpiPw E{Z, MIX, bpw};
        pg8::gemm_phase<pg8::EpiPw, pg8::StaticOrder, true, true>(ldsl, g, S, E);
    }
    SEAM(4);
    if (IN(5)) REPS(5) {
        pg8::Gemm g{MIX, WOUT_T, M, DM, DM}; pg8::StaticOrder S; S.init(M, DM, G, bx);
        pg8::EpiOut E{x, args.out, MOD};
        pg8::gemm_phase<pg8::EpiOut, pg8::StaticOrder, true, true>(ldsl, g, S, E);
    }
#undef IN
#undef SEAM
}

extern "C" void kernel_launch(void* const* d_in, const int* in_sizes, int n_in, void* d_out, int out_size, void* d_ws, size_t ws_size, hipStream_t stream) {
    static int grid = 0;
    if (grid == 0) {
        if (n_in != 17 || in_sizes[0] != M * DM || out_size != M * DM || ws_size < WS_END) { fprintf(stderr, "kernel_launch: unexpected shapes (n_in %d, in0 %d, out %d, ws %zu); nothing launched\n", n_in, n_in > 0 ? in_sizes[0] : -1, out_size, ws_size); grid = -1; return; }
        int dev = 0, cus = 0, per_cu = 0;
        if (hipGetDevice(&dev) != hipSuccess || hipDeviceGetAttribute(&cus, hipDeviceAttributeMultiprocessorCount, dev) != hipSuccess) { grid = -1; return; }
        if (hipFuncSetAttribute((const void*)hybrid_fwd, hipFuncAttributeMaxDynamicSharedMemorySize, LDS_BYTES) != hipSuccess) { fprintf(stderr, "kernel_launch: hipFuncSetAttribute failed\n"); grid = -1; return; }
        if (hipOccupancyMaxActiveBlocksPerMultiprocessor(&per_cu, (const void*)hybrid_fwd, NWAVES * 64, LDS_BYTES) != hipSuccess || per_cu < 1) { fprintf(stderr, "kernel_launch: occupancy query says %d\n", per_cu); per_cu = 1; }
        (void)hipGetLastError();
        grid = cus * per_cu;
    }
    if (grid < 0) return;
    if (hipMemsetAsync((char*)d_ws + WS_CTL, 0, CTL_ZERO_BYTES, stream) != hipSuccess) { fprintf(stderr, "kernel_launch: memset failed\n"); return; }
    Args a{};
    for (int i = 0; i < 17; ++i) a.in[i] = (const float*)d_in[i];
    a.out = (float*)d_out; a.ws = (unsigned char*)d_ws;
#if MK_N_LAUNCHES == 1
    a.ph_lo = 0; a.ph_hi = N_PHASES;
    void* kargs[] = {&a};
    hipError_t e = hipLaunchCooperativeKernel((const void*)hybrid_fwd, dim3(grid), dim3(NWAVES * 64), kargs, LDS_BYTES, stream);
    if (e != hipSuccess) fprintf(stderr, "kernel_launch: cooperative launch failed: %s (grid %d)\n", hipGetErrorString(e), grid);
#else
    for (int p = 0; p < N_PHASES; ++p) { a.ph_lo = p; a.ph_hi = p + 1; hipLaunchKernelGGL(hybrid_fwd, dim3(grid), dim3(NWAVES * 64), LDS_BYTES, stream, a); }
#endif
}
```

```cpp
#include <hip/hip_runtime.h>
#include <hip/hip_cooperative_groups.h>
#include <cstdio>
#include <cstdint>
namespace pg8 {
#define PG8_LAS __attribute__((address_space(3)))
typedef unsigned short bf16_t;
typedef short bf16x8 __attribute__((ext_vector_type(8)));
typedef float f32x4 __attribute__((ext_vector_type(4)));
typedef unsigned u32x4 __attribute__((ext_vector_type(4)));
constexpr int BM = 256, BK = 64, HALF = 128, HTB = HALF * BK * 2  , STAGE_BYTES = 8 * HTB, NXCD = 8, WGM = 8;

__host__ __device__ __forceinline__ int lds_byte(int r, int c) { const int st = (r >> 4) * 2 + (c >> 5), rr = r & 15, cc = c & 31, ob = rr * 64 + cc * 2; return st * 1024 + (ob ^ (((ob >> 9) & 1) << 5)); }
__host__ __device__ __forceinline__ void stage_rc(int b, int& R, int& C) { const int st = b / 1024, sb = b % 1024, swz = sb ^ (((sb >> 9) & 1) << 5); R = (st >> 1) * 16 + swz / 64; C = (st & 1) * 32 + (swz % 64) / 2; }
__host__ __device__ __forceinline__ int perm32(int rho) { const int n = rho >> 4, i = rho & 15; return 8 * (i >> 2) + 4 * n + (i & 3); }

struct Unit { int pm, pn; };
struct Gemm { const bf16_t* A; const bf16_t* Bt; int M, N, K; };

struct StaticOrder {
    int nM, nN, nwg, G, c;
    __host__ __device__ void init(int M, int N, int G_, int c_) { nM = M / BM; nN = N / BM; nwg = nM * nN; G = G_; c = c_; }
    __host__ __device__ bool next(int i, Unit& u) const {
        const long L = (long)i * G + c; if (L >= nwg) return false;
        int wgid = (int)L; { const int q = nwg / NXCD, r = nwg % NXCD, xcd = wgid % NXCD, off = wgid / NXCD; wgid = (xcd < r ? xcd * (q + 1) : r * (q + 1) + (xcd - r) * q) + off; }
        const int nig = WGM * nN, gid = wgid / nig, fm = gid * WGM, gsz = (nM - fm) < WGM ? (nM - fm) : WGM;
        u.pm = fm + ((wgid % nig) % gsz); u.pn = (wgid % nig) / gsz; return true;
    }
    __device__ __forceinline__ void a_ready(const Unit&) const {}
    __device__ __forceinline__ void done(const Unit&) const {}
};
__device__ __forceinline__ unsigned cvt_pk_bf16(float lo, float hi) { unsigned r; asm volatile("v_cvt_pk_bf16_f32 %0, %1, %2" : "=v"(r) : "v"(lo), "v"(hi)); return r; }
typedef float f32x2 __attribute__((ext_vector_type(2)));
constexpr float QC2 = 0.125f * 1.4426950408889634f;
__device__ __forceinline__ float silu_f(float v) { return v * __builtin_amdgcn_rcpf(1.0f + __expf(-v)); }
__device__ __forceinline__ float sigm_f(float v) { return __builtin_amdgcn_rcpf(1.0f + __expf(-v)); }
__device__ __forceinline__ float bf_lo(unsigned w) { return __uint_as_float(w << 16); }
__device__ __forceinline__ float bf_hi(unsigned w) { return __uint_as_float(w & 0xffff0000u); }

struct OrderIn {
    StaticOrder so;
    __device__ void init(int G_, int c_) { so.init(32768, 2816, G_, c_); }
    __device__ bool next(int i, Unit& u) const {
        const long L = (long)i * so.G + so.c;
        if (L < so.nwg) return so.next(i, u);
        const int e = (int)(L - so.nwg); if (e >= 16) return false;
        u.pm = 128 + e; u.pn = 2; return true;
    }
    __device__ __forceinline__ void a_ready(const Unit&) const {}
    __device__ __forceinline__ void done(const Unit&) const {}
};

struct EpiIn {
    static constexpr bool PERM = true, AFTER_DRAIN = false;
    bf16_t *Q, *KA, *VA, *Z, *UG; const float* rope; const float *qnw, *knw;
    __device__ __forceinline__ void operator()(const f32x4 (&acc)[2][2][4][2], const Unit& u, int wr, int wc, int fr, int fq) const {
        const int pn = u.pn;
        const int rowb = u.pm * BM + wr * 64 + fr;
        if (pn <= 2) {
            const bool isq = pn < 2, isv = (pn == 2) && (wc >= 2), isctx = u.pm >= 128;
            const int d1 = (fq & 1) * 8 + (fq >> 1) * 32;
            float w1[8], w2[8];
            { const float* nw = isq ? qnw : knw; const float sc = isq ? QC2 : 1.0f;
#pragma unroll
              for (int e = 0; e < 8; ++e) { w1[e] = nw[d1 + e] * sc; w2[e] = nw[d1 + 16 + e] * sc; } }
#pragma unroll
            for (int ai = 0; ai < 2; ++ai)
#pragma unroll
                for (int m = 0; m < 4; ++m) {
                    const int row = rowb + ai * HALF + m * 16;
                    float x1[8], x2[8];
#pragma unroll
                    for (int n = 0; n < 2; ++n)
#pragma unroll
                        for (int i = 0; i < 4; ++i) { x1[4 * n + i] = acc[ai][0][m][n][i]; x2[4 * n + i] = acc[ai][1][m][n][i]; }
                    bf16_t* dst;
                    if (isq) dst = Q + (size_t)row * 512 + (4 * pn + wc) * 64 + d1;
                    else {
                        size_t pos;
                        if (isctx) { const int r2 = row - 32768; pos = (size_t)(r2 >> 8) * 2304 + (r2 & 255); }
                        else pos = (size_t)(row >> 11) * 2304 + 256 + (row & 2047);
                        dst = (isv ? VA : KA) + pos * 128 + (wc & 1) * 64 + d1;
                    }
                    if (!isv) {
                        float ss = 0.f;
#pragma unroll
                        for (int e = 0; e < 8; ++e) ss += x1[e] * x1[e] + x2[e] * x2[e];
                        ss += __shfl_xor(ss, 16); ss += __shfl_xor(ss, 32);
                        const float rinv = rsqrtf(ss * (1.0f / 64.0f) + 1e-6f);
#pragma unroll
                        for (int e = 0; e < 8; ++e) { x1[e] = x1[e] * rinv * w1[e]; x2[e] = x2[e] * rinv * w2[e]; }
                        if (!isctx) {
                            const int t = row & 2047, pos = (fq >> 1) ? (t & 63) : (t >> 6);
                            const f32x4* rp = (const f32x4*)(rope + (size_t)(pos * 16 + (fq & 1) * 8) * 2);
#pragma unroll
                            for (int e2 = 0; e2 < 4; ++e2) { const f32x4 cs = rp[e2];
                                { const float a = x1[2 * e2], b = x2[2 * e2]; x1[2 * e2] = a * cs[0] - b * cs[1]; x2[2 * e2] = a * cs[1] + b * cs[0]; }
                                { const float a = x1[2 * e2 + 1], b = x2[2 * e2 + 1]; x1[2 * e2 + 1] = a * cs[2] - b * cs[3]; x2[2 * e2 + 1] = a * cs[3] + b * cs[2]; } }
                        }
                    }
                    u32x4 o1, o2;
                    o1.x = cvt_pk_bf16(x1[0], x1[1]); o1.y = cvt_pk_bf16(x1[2], x1[3]); o1.z = cvt_pk_bf16(x1[4], x1[5]); o1.w = cvt_pk_bf16(x1[6], x1[7]);
                    o2.x = cvt_pk_bf16(x2[0], x2[1]); o2.y = cvt_pk_bf16(x2[2], x2[3]); o2.z = cvt_pk_bf16(x2[4], x2[5]); o2.w = cvt_pk_bf16(x2[6], x2[7]);
                    *(u32x4*)dst = o1; *(u32x4*)(dst + 16) = o2;
                }
        } else if (pn >= 5 && pn <= 8) {
            const int c0 = (pn - 5) * 128 + wc * 32 + 8 * fq;
#pragma unroll
            for (int ai = 0; ai < 2; ++ai)
#pragma unroll
                for (int m = 0; m < 4; ++m) {
                    const int row = rowb + ai * HALF + m * 16;
                    const f32x4 a0 = acc[ai][0][m][0], a1 = acc[ai][0][m][1], g0 = acc[ai][1][m][0], g1 = acc[ai][1][m][1];
                    u32x4 w;
                    w.x = cvt_pk_bf16(a0[0] * sigm_f(g0[0]), a0[1] * sigm_f(g0[1])); w.y = cvt_pk_bf16(a0[2] * sigm_f(g0[2]), a0[3] * sigm_f(g0[3]));
                    w.z = cvt_pk_bf16(a1[0] * sigm_f(g1[0]), a1[1] * sigm_f(g1[1])); w.w = cvt_pk_bf16(a1[2] * sigm_f(g1[2]), a1[3] * sigm_f(g1[3]));
                    *(u32x4*)(UG + (size_t)row * 512 + c0) = w;
                }
        } else {
            const int zc = (pn <= 4 ? (pn - 3) * 256 : 512 + (pn - 9) * 256) + wc * 32 + 8 * fq;
#pragma unroll
            for (int ai = 0; ai < 2; ++ai)
#pragma unroll
                for (int m = 0; m < 4; ++m) {
                    const int row = rowb + ai * HALF + m * 16;
#pragma unroll
                    for (int bj = 0; bj < 2; ++bj) { const f32x4 v0 = acc[ai][bj][m][0], v1 = acc[ai][bj][m][1];
                        u32x4 w; w.x = cvt_pk_bf16(silu_f(v0[0]), silu_f(v0[1])); w.y = cvt_pk_bf16(silu_f(v0[2]), silu_f(v0[3]));
                        w.z = cvt_pk_bf16(silu_f(v1[0]), silu_f(v1[1])); w.w = cvt_pk_bf16(silu_f(v1[2]), silu_f(v1[3]));
                        *(u32x4*)(Z + (size_t)row * 1024 + zc + bj * HALF) = w; }
                }
        }
    }
};

struct EpiPw {
    static constexpr bool PERM = true, AFTER_DRAIN = false;
    const bf16_t* Z; bf16_t* MIX; const float* bias;
    __device__ __forceinline__ void operator()(const f32x4 (&acc)[2][2][4][2], const Unit& u, int wr, int wc, int fr, int fq) const {
        const int rowb = u.pm * BM + wr * 64 + fr, col0 = u.pn * BM + wc * 32 + 8 * fq;
        f32x4 bv[2][2];
#pragma unroll
        for (int bj = 0; bj < 2; ++bj)
#pragma unroll
            for (int n = 0; n < 2; ++n) bv[bj][n] = *(const f32x4*)(bias + col0 + bj * HALF + 4 * n);
        u32x4 zz[2][4][2];
#pragma unroll
        for (int ai = 0; ai < 2; ++ai)
#pragma unroll
            for (int m = 0; m < 4; ++m) { const size_t off = (size_t)(rowb + ai * HALF + m * 16) * 1024 + 512 + col0;
#pragma unroll
                for (int bj = 0; bj < 2; ++bj) zz[ai][m][bj] = *(const u32x4*)(Z + off + bj * HALF); }
        asm volatile("" ::: "memory");
#pragma unroll
        for (int ai = 0; ai < 2; ++ai)
#pragma unroll
            for (int m = 0; m < 4; ++m) {
                const size_t off = (size_t)(rowb + ai * HALF + m * 16) * 1024 + 512 + col0;
#pragma unroll
                for (int bj = 0; bj < 2; ++bj) {
                    const u32x4 z = zz[ai][m][bj];
                    const f32x4 v0 = acc[ai][bj][m][0] + bv[bj][0], v1 = acc[ai][bj][m][1] + bv[bj][1];
                    u32x4 w;
                    w.x = cvt_pk_bf16(v0[0] * bf_lo(z.x), v0[1] * bf_hi(z.x)); w.y = cvt_pk_bf16(v0[2] * bf_lo(z.y), v0[3] * bf_hi(z.y));
                    w.z = cvt_pk_bf16(v1[0] * bf_lo(z.z), v1[1] * bf_hi(z.z)); w.w = cvt_pk_bf16(v1[2] * bf_lo(z.w), v1[3] * bf_hi(z.w));
                    *(u32x4*)(MIX + off + bj * HALF) = w;
                }
            }
    }
};

struct EpiOut {
    static constexpr bool PERM = false, AFTER_DRAIN = false;
    const float* x; float* out; const float* mod;
    __device__ __forceinline__ void operator()(const f32x4 (&acc)[2][2][4][2], const Unit& u, int wr, int wc, int fr, int fq) const {
        const int rowb = u.pm * BM + wr * 64 + fr, col0 = u.pn * BM + wc * 32 + 4 * fq;
        const float* gp = mod + (size_t)(u.pm >> 3) * 3072 + 2048 + col0;
        f32x4 gv[2][2];
#pragma unroll
        for (int bj = 0; bj < 2; ++bj)
#pragma unroll
            for (int n = 0; n < 2; ++n) gv[bj][n] = *(const f32x4*)(gp + bj * HALF + n * 16);
        const float* __restrict__ xr_ = x; float* __restrict__ or_ = out;
#pragma unroll
        for (int ai = 0; ai < 2; ++ai) {
            f32x4 xv[4][2][2];
#pragma unroll
            for (int m = 0; m < 4; ++m) { const size_t off = (size_t)(rowb + ai * HALF + m * 16) * 1024 + col0;
#pragma unroll
                for (int bj = 0; bj < 2; ++bj)
#pragma unroll
                    for (int n = 0; n < 2; ++n) xv[m][bj][n] = *(const f32x4*)(xr_ + off + bj * HALF + n * 16); }
            asm volatile("" ::: "memory");
#pragma unroll
            for (int m = 0; m < 4; ++m) { const size_t off = (size_t)(rowb + ai * HALF + m * 16) * 1024 + col0;
#pragma unroll
                for (int bj = 0; bj < 2; ++bj)
#pragma unroll
                    for (int n = 0; n < 2; ++n) *(f32x4*)(or_ + off + bj * HALF + n * 16) = xv[m][bj][n] + gv[bj][n] * acc[ai][bj][m][n]; }
            asm volatile("" ::: "memory");
        }
    }
};
template <class Epi, class Sched, bool ALIGN_EPI = false, bool SP2 = false>
__device__ __forceinline__ void gemm_phase(PG8_LAS unsigned char* lds, const Gemm g, const Sched& S, const Epi& E) {
    const int tid = threadIdx.x, wid = __builtin_amdgcn_readfirstlane(tid >> 6), lane = tid & 63, wr = wid >> 2, wc = wid & 3, fr = lane & 15, fq = lane >> 4;
    const int K = g.K, nt = K / BK;
    unsigned voffA[2], voffB[2];
#pragma unroll
    for (int i = 0; i < 2; ++i) { int R, C; stage_rc(tid * 16 + i * 8192, R, C); const int Rb = Epi::PERM ? ((R & ~31) + perm32(R & 31)) : R;
        voffA[i] = (unsigned)(R * K + C) * 2u; voffB[i] = (unsigned)(Rb * K + C) * 2u; }
    const size_t kstep = (size_t)(BK * 2);
    const size_t hstep = (size_t)HALF * K * 2;
    const size_t tstep = 2 * hstep;
    const unsigned ldsw = (unsigned)wid * 1024u;
    const int aoff = lds_byte(wr * 64 + fr, fq * 8), boff = lds_byte(wc * 32 + fr, fq * 8);
#define PG8_SA(b, h) (((b) * 2 + (h)) * HTB)
#define PG8_SB(b, h) ((4 + (b) * 2 + (h)) * HTB)
#define PG8_STAGE(bufoff, gbase, voff) do { _Pragma("unroll") for (int _i = 0; _i < 2; ++_i) \
        __builtin_amdgcn_global_load_lds((const unsigned*)((const char*)(gbase) + (voff)[_i]), (PG8_LAS unsigned*)(lds + (bufoff) + ldsw + _i * 8192), 16, 0, 0); } while (0)
#define PG8_LDA(dst, b, h) do { _Pragma("unroll") for (int m = 0; m < 4; ++m) _Pragma("unroll") for (int k = 0; k < 2; ++k) dst[m][k] = *(const PG8_LAS bf16x8*)(lds + PG8_SA(b, h) + aoff + m * 2048 + k * 1024); } while (0)
#define PG8_LDB(dst, b, h) do { _Pragma("unroll") for (int n = 0; n < 2; ++n) _Pragma("unroll") for (int k = 0; k < 2; ++k) dst[n][k] = *(const PG8_LAS bf16x8*)(lds + PG8_SB(b, h) + boff + n * 2048 + k * 1024); } while (0)
#define PG8_MMA(ai, bj, At, Bt) do { __builtin_amdgcn_s_setprio(1); _Pragma("unroll") for (int m = 0; m < 4; ++m) _Pragma("unroll") for (int n = 0; n < 2; ++n) _Pragma("unroll") for (int k = 0; k < 2; ++k) \
        acc[ai][bj][m][n] = __builtin_amdgcn_mfma_f32_16x16x32_bf16(Bt[n][k], At[m][k], acc[ai][bj][m][n], 0, 0, 0); __builtin_amdgcn_s_setprio(0); } while (0)
#define PG8_WAIT_V(n) asm volatile("s_waitcnt vmcnt(" #n ")" ::: "memory")
#define PG8_WAIT_L(n) asm volatile("s_waitcnt lgkmcnt(" #n ")" ::: "memory")
#define PG8_BAR __builtin_amdgcn_s_barrier()
#define PG8_SCHED __builtin_amdgcn_sched_barrier(0)
    Unit cur, nxt; int ui = 0;
    if (!S.next(0, cur)) return;
    f32x4 acc[2][2][4][2];
#pragma unroll
    for (int a = 0; a < 2; ++a)
#pragma unroll
        for (int b = 0; b < 2; ++b)
#pragma unroll
            for (int m = 0; m < 4; ++m)
#pragma unroll
                for (int n = 0; n < 2; ++n) acc[a][b][m][n] = (f32x4){0.f, 0.f, 0.f, 0.f};
    bf16x8 At[4][2], B0[2][2], B1[2][2];
    const char* cA = (const char*)g.A + (size_t)cur.pm * tstep; const char* cB = (const char*)g.Bt + (size_t)cur.pn * tstep;
    S.a_ready(cur);
    if constexpr (SP2) {
        PG8_STAGE(PG8_SB(0, 0), cB, voffB); PG8_STAGE(PG8_SB(0, 1), cB + hstep, voffB); PG8_STAGE(PG8_SA(0, 0), cA, voffA); PG8_STAGE(PG8_SA(0, 1), cA + hstep, voffA);
        if (wr == 1) PG8_BAR;
        PG8_WAIT_V(2); PG8_BAR;
        PG8_STAGE(PG8_SB(1, 0), cB + kstep, voffB); PG8_STAGE(PG8_SA(1, 0), cA + kstep, voffA); PG8_STAGE(PG8_SB(1, 1), cB + hstep + kstep, voffB);
        PG8_WAIT_V(6); PG8_BAR;
    } else {
        PG8_STAGE(PG8_SB(0, 0), cB, voffB); PG8_STAGE(PG8_SA(0, 0), cA, voffA); PG8_STAGE(PG8_SB(0, 1), cB + hstep, voffB); PG8_STAGE(PG8_SA(0, 1), cA + hstep, voffA);
        if (wr == 1) PG8_BAR;
        PG8_WAIT_V(4); PG8_BAR;
        PG8_STAGE(PG8_SB(1, 0), cB + kstep, voffB); PG8_STAGE(PG8_SA(1, 0), cA + kstep, voffA); PG8_STAGE(PG8_SB(1, 1), cB + hstep + kstep, voffB);
        PG8_WAIT_V(6); PG8_BAR;
    }
    for (;;) {
        const bool has_next = S.next(ui + 1, nxt);
        const char* nA = has_next ? (const char*)g.A + (size_t)nxt.pm * tstep : cA; const char* nB = has_next ? (const char*)g.Bt + (size_t)nxt.pn * tstep : cB;
        for (int t = 0; t < nt; t += 2) {
            const bool last = (t == nt - 2);
            const char* a1 = cA + (size_t)(t + 1) * kstep;
            const char* a2 = last ? nA : cA + (size_t)(t + 2) * kstep; const char* b2 = last ? nB : cB + (size_t)(t + 2) * kstep;
            const char* a3 = a2 + kstep; const char* b3 = b2 + kstep;
            if (last && has_next) S.a_ready(nxt);
            if constexpr (SP2) {
            PG8_LDB(B0, 0, 0); PG8_LDB(B1, 0, 1); PG8_SCHED; PG8_LDA(At, 0, 0); PG8_STAGE(PG8_SA(1, 1), a1 + hstep, voffA);
            PG8_WAIT_V(8); PG8_WAIT_L(0); PG8_BAR; PG8_MMA(0, 0, At, B0); PG8_MMA(0, 1, At, B1); PG8_BAR; PG8_SCHED;
            PG8_LDA(At, 0, 1); PG8_STAGE(PG8_SB(0, 0), b2, voffB); PG8_STAGE(PG8_SB(0, 1), b2 + hstep, voffB); PG8_STAGE(PG8_SA(0, 0), a2, voffA);
            PG8_WAIT_V(8); PG8_WAIT_L(0); PG8_BAR; PG8_MMA(1, 0, At, B0); PG8_MMA(1, 1, At, B1); PG8_BAR; PG8_SCHED;
            PG8_LDB(B0, 1, 0); PG8_LDB(B1, 1, 1); PG8_SCHED; PG8_LDA(At, 1, 0); PG8_STAGE(PG8_SA(0, 1), a2 + hstep, voffA);
            PG8_WAIT_V(8); PG8_WAIT_L(0); PG8_BAR; PG8_MMA(0, 0, At, B0); PG8_MMA(0, 1, At, B1); PG8_BAR; PG8_SCHED;
            PG8_LDA(At, 1, 1); PG8_STAGE(PG8_SB(1, 0), b3, voffB); PG8_STAGE(PG8_SB(1, 1), b3 + hstep, voffB); PG8_STAGE(PG8_SA(1, 0), a3, voffA);
            PG8_WAIT_V(8); PG8_WAIT_L(0); PG8_BAR; PG8_MMA(1, 0, At, B0); PG8_MMA(1, 1, At, B1); PG8_BAR; PG8_SCHED;
            } else {
            PG8_LDB(B0, 0, 0); PG8_SCHED; PG8_LDA(At, 0, 0); PG8_STAGE(PG8_SA(1, 1), a1 + hstep, voffA);
            PG8_WAIT_L(8); PG8_BAR; PG8_WAIT_L(0); PG8_MMA(0, 0, At, B0); PG8_BAR; PG8_SCHED;
            PG8_LDB(B1, 0, 1); PG8_STAGE(PG8_SB(0, 0), b2, voffB);
            PG8_BAR; PG8_WAIT_L(0); PG8_MMA(0, 1, At, B1); PG8_BAR;
            PG8_LDA(At, 0, 1); PG8_STAGE(PG8_SA(0, 0), a2, voffA);
            PG8_BAR; PG8_WAIT_L(0); PG8_MMA(1, 0, At, B0); PG8_BAR; PG8_SCHED;
            PG8_STAGE(PG8_SB(0, 1), b2 + hstep, voffB);
            PG8_WAIT_V(6); PG8_BAR; PG8_MMA(1, 1, At, B1); PG8_BAR;
            PG8_LDB(B0, 1, 0); PG8_SCHED; PG8_LDA(At, 1, 0); PG8_STAGE(PG8_SA(0, 1), a2 + hstep, voffA);
            PG8_WAIT_L(8); PG8_BAR; PG8_WAIT_L(0); PG8_MMA(0, 0, At, B0); PG8_BAR; PG8_SCHED;
            PG8_LDB(B1, 1, 1); PG8_STAGE(PG8_SB(1, 0), b3, voffB);
            PG8_BAR; PG8_WAIT_L(0); PG8_MMA(0, 1, At, B1); PG8_BAR;
            PG8_LDA(At, 1, 1); PG8_STAGE(PG8_SA(1, 0), a3, voffA);
            PG8_BAR; PG8_WAIT_L(0); PG8_MMA(1, 0, At, B0); PG8_BAR; PG8_SCHED;
            PG8_STAGE(PG8_SB(1, 1), b3 + hstep, voffB);
            PG8_WAIT_V(6); PG8_BAR; PG8_MMA(1, 1, At, B1); PG8_BAR;
            }
        }
        if constexpr (ALIGN_EPI) { if (wr == 0) PG8_BAR; }
        if constexpr (!Epi::AFTER_DRAIN) { E(acc, cur, wr, wc, fr, fq); S.done(cur); }
        if (!has_next) break;
#pragma unroll
        for (int a = 0; a < 2; ++a)
#pragma unroll
            for (int b = 0; b < 2; ++b)
#pragma unroll
                for (int m = 0; m < 4; ++m)
#pragma unroll
                    for (int n = 0; n < 2; ++n) acc[a][b][m][n] = (f32x4){0.f, 0.f, 0.f, 0.f};
        cur = nxt; cA = nA; cB = nB; ++ui;
        if constexpr (ALIGN_EPI) { if (wr == 1) PG8_BAR; }
    }
    PG8_WAIT_V(0);
    if constexpr (!ALIGN_EPI) { if (wr == 0) PG8_BAR; }
    PG8_BAR;
    if constexpr (Epi::AFTER_DRAIN) { E.fused(acc, cur, wr, wc, fr, fq, lds, wid, lane); S.done(cur); }
#undef PG8_SA
#undef PG8_SB
#undef PG8_STAGE
#undef PG8_LDA
#undef PG8_LDB
#undef PG8_MMA
#undef PG8_WAIT_V
#undef PG8_WAIT_L
#undef PG8_BAR
#undef PG8_SCHED
}
}
#include <hip/hip_bf16.h>
#include <cmath>
namespace attn_body {
using bf16=__hip_bfloat16;
using bf16x8=__attribute__((ext_vector_type(8)))short;
using s16x4=__attribute__((ext_vector_type(4)))short;
using f32x16=__attribute__((ext_vector_type(16)))float;
using u32x4=__attribute__((ext_vector_type(4)))unsigned;
constexpr int SEQ=2048,SKV=2304,D=64,QP=512,KP=128,OP=1024;
constexpr int NW=8,QBLK=32,QB=QBLK*NW,KVBLK=64,NQB=SEQ/QB;
constexpr int ATTN_UNIT_ROWS=QB;
__device__ __forceinline__ int crow(int r,int hi){return (r&3)+8*(r>>2)+4*hi;}
#define SBAR() __builtin_amdgcn_sched_barrier(0)
__device__ __forceinline__ void cmask(f32x16&p0,f32x16&p1,int jb,int qrel,int hi){
  const float NEG=-INFINITY; int kb=64*jb+4*hi;
  #pragma unroll
  for(int r=0;r<16;++r){int kv=kb+(r&3)+8*(r>>2); if(kv>qrel)p0[r]=NEG; if(kv+32>qrel)p1[r]=NEG;}
}

constexpr int NSLOT=3, SLOTB=8192;
constexpr int LDS_K=0, LDS_V=NSLOT*SLOTB, LDS_WS=2*NSLOT*SLOTB, LDS_OST=LDS_WS+NW*64*4, LDS_BYTES=LDS_OST+NW*4096;
constexpr float C2=0.125f*1.4426950408889634f;
__device__ __forceinline__ void glds16(const void*gsrc,unsigned lds_dst){unsigned keep;
  asm volatile("s_mov_b32 %0, m0\n\ts_mov_b32 m0, %2\n\ts_nop 0\n\tglobal_load_lds_dwordx4 %1, off\n\ts_mov_b32 m0, %0":"=&s"(keep):"v"(gsrc),"s"(lds_dst):"memory");}
__device__ __forceinline__ float max3f(float a,float b,float c){float r;asm("v_max3_f32 %0, %1, %2, %3":"=v"(r):"v"(a),"v"(b),"v"(c));return r;}
__device__ __forceinline__ float max2f(float a,float b){float r;asm("v_max_f32_e32 %0, %1, %2":"=v"(r):"v"(a),"v"(b));return r;}
__device__ __forceinline__ float fadd_s(float a,float b){float r;asm("v_add_f32_e32 %0, %1, %2":"=v"(r):"v"(a),"v"(b));return r;}
__device__ __forceinline__ float fsub_s(float a,float b){float r;asm("v_sub_f32_e32 %0, %1, %2":"=v"(r):"v"(a),"v"(b));return r;}
typedef float f32x2_t __attribute__((ext_vector_type(2))); typedef __bf16 bf16x2_t __attribute__((ext_vector_type(2)));
__device__ __forceinline__ unsigned cvtpk_s(float lo,float hi){f32x2_t v={lo,hi};bf16x2_t b=__builtin_convertvector(v,bf16x2_t);return __builtin_bit_cast(unsigned,b);}
#define WAIT_BAR(N) asm volatile("s_waitcnt vmcnt(" #N ") lgkmcnt(0)\n\ts_barrier":::"memory")

__device__ __forceinline__ void qkt(f32x16&p0,f32x16&p1,const char*Kslot,const bf16x8*qr,const f32x16&negm,int r32,int hi){
  const char*kb=Kslot+hi*1024+r32*16;
  #pragma unroll
  for(int d0=0;d0<4;++d0){
    const bf16x8 b0=*reinterpret_cast<const bf16x8*>(kb+d0*2048);
    const bf16x8 b1=*reinterpret_cast<const bf16x8*>(kb+d0*2048+512);
    if(d0==0){p0=__builtin_amdgcn_mfma_f32_32x32x16_bf16(b0,qr[0],negm,0,0,0);p1=__builtin_amdgcn_mfma_f32_32x32x16_bf16(b1,qr[0],negm,0,0,0);}
    else{p0=__builtin_amdgcn_mfma_f32_32x32x16_bf16(b0,qr[d0],p0,0,0,0);p1=__builtin_amdgcn_mfma_f32_32x32x16_bf16(b1,qr[d0],p1,0,0,0);}}
}
typedef __attribute__((address_space(3))) const char* lds_cptr;
typedef short v4i16_t __attribute__((ext_vector_type(4)));
__device__ __forceinline__ void kload8(bf16x8*kf,lds_cptr kp){
  kf[0]=*(const __attribute__((address_space(3))) bf16x8*)(kp);      kf[1]=*(const __attribute__((address_space(3))) bf16x8*)(kp+512);
  kf[2]=*(const __attribute__((address_space(3))) bf16x8*)(kp+2048); kf[3]=*(const __attribute__((address_space(3))) bf16x8*)(kp+2560);
  kf[4]=*(const __attribute__((address_space(3))) bf16x8*)(kp+4096); kf[5]=*(const __attribute__((address_space(3))) bf16x8*)(kp+4608);
  kf[6]=*(const __attribute__((address_space(3))) bf16x8*)(kp+6144); kf[7]=*(const __attribute__((address_space(3))) bf16x8*)(kp+6656);
}
__device__ __forceinline__ void kload2(bf16x8*kf,lds_cptr kp,int j){ kf[2*j]=*(const __attribute__((address_space(3))) bf16x8*)(kp+j*2048); kf[2*j+1]=*(const __attribute__((address_space(3))) bf16x8*)(kp+j*2048+512); }
__device__ __forceinline__ s16x4 vtr(lds_cptr p){ return __builtin_bit_cast(s16x4,__builtin_amdgcn_ds_read_tr16_b64_v4i16((__attribute__((address_space(3))) v4i16_t*)p)); }
__device__ __forceinline__ float rowmax(const f32x16&p0,const f32x16&p1){
  float a=max3f(p0[0],p0[1],p1[0]),b=max3f(p0[2],p0[3],p1[1]);a=max3f(a,p1[2],p1[3]);
  #pragma unroll
  for(int r=4;r<16;r+=4){a=max3f(a,p0[r],p0[r+1]);b=max3f(b,p0[r+2],p0[r+3]);a=max3f(a,p1[r],p1[r+1]);b=max3f(b,p1[r+2],p1[r+3]);}
  const float m=max2f(a,b);
  auto rr=__builtin_amdgcn_permlane32_swap(__float_as_uint(m),__float_as_uint(m),false,false);
  return max2f(__uint_as_float(rr[0]),__uint_as_float(rr[1]));
}
__device__ __forceinline__ void pv(f32x16*o,int vb,bf16x8 pa0,bf16x8 pa1,bf16x8 pa2,bf16x8 pa3){
  #pragma unroll
  for(int d0=0;d0<2;++d0){s16x4 lo[4],hi[4];
    #pragma unroll
    for(int ks=0;ks<4;++ks){
      asm volatile("ds_read_b64_tr_b16 %0,%1 offset:%c2":"=&v"(lo[ks]):"v"(vb),"i"(d0*4096+ks*1024):"memory");
      asm volatile("ds_read_b64_tr_b16 %0,%1 offset:%c2":"=&v"(hi[ks]):"v"(vb),"i"(d0*4096+ks*1024+512):"memory");}
    asm volatile("s_waitcnt lgkmcnt(0)":::"memory");SBAR();
    #define PK(k) (bf16x8){lo[k][0],lo[k][1],lo[k][2],lo[k][3],hi[k][0],hi[k][1],hi[k][2],hi[k][3]}
    o[d0]=__builtin_amdgcn_mfma_f32_32x32x16_bf16(pa0,PK(0),o[d0],0,0,0);
    o[d0]=__builtin_amdgcn_mfma_f32_32x32x16_bf16(pa1,PK(1),o[d0],0,0,0);
    o[d0]=__builtin_amdgcn_mfma_f32_32x32x16_bf16(pa2,PK(2),o[d0],0,0,0);
    o[d0]=__builtin_amdgcn_mfma_f32_32x32x16_bf16(pa3,PK(3),o[d0],0,0,0);
    #undef PK
  }
}

#ifndef ATTN_STORE16
#define ATTN_STORE16(p,v) (*(u32x4*)(p)=(v))
#endif
template<int THRL,bool FIX> __device__ __forceinline__ void attn_unit(float mfix,int b,int h,int qb,const bf16*Q,const bf16*__restrict__ K,const bf16*__restrict__ V,const bf16*__restrict__ Z,bf16*O,char*shm){
  const int tid=threadIdx.x,lane=tid&63,r32=lane&31,hi=lane>>5; const int wid=__builtin_amdgcn_readfirstlane(tid>>6);
  const long rowbase=(long)b*SEQ; const int q0=qb*QB;
  const bf16*Qw=Q+(rowbase+q0+wid*QBLK)*QP+h*D;
  const long kvbase=(long)b*SKV*KP+(h>>2)*D; const bf16*Kh=K+kvbase,*Vh=V+kvbase;
  const unsigned lds0=(unsigned)(uintptr_t)shm;
  float*wsf=(float*)(shm+LDS_WS)+wid*64;
  const bf16*ksrc=Kh+(long)lane*KP+wid*8;
  const bf16*vsrc=Vh+(long)(16*(wid&3)+(lane>>2))*KP+(wid>>2)*32+(lane&3)*8;
  const unsigned kdst=lds0+LDS_K+wid*1024, vdst=lds0+LDS_V+wid*1024;
  #define DMA_K(t,slot) glds16(ksrc+(long)(t)*KVBLK*KP,(unsigned)__builtin_amdgcn_readfirstlane(kdst+(slot)))
  #define DMA_V(t,slot) glds16(vsrc+(long)(t)*KVBLK*KP,(unsigned)__builtin_amdgcn_readfirstlane(vdst+(slot)))
  const int vb0=(int)(lds0+LDS_V)+((lane>>4)&1)*32+(lane&3)*8+(4*hi+((lane&15)>>2))*64;
  const char*Kbase=shm+LDS_K; bf16x8 kf[8];
  const lds_cptr shm3=(lds_cptr)shm; const lds_cptr kp0=shm3+LDS_K+hi*1024+r32*16; const lds_cptr vp0=shm3+LDS_V+((lane>>4)&1)*32+(lane&3)*8+(4*hi+((lane&15)>>2))*64;
  constexpr int NT=SKV/KVBLK;
  DMA_K(0,0);DMA_V(0,0);DMA_K(1,SLOTB);
  bf16x8 qr[4];
  #pragma unroll
  for(int d0=0;d0<4;++d0)qr[d0]=*reinterpret_cast<const bf16x8*>(&Qw[(long)r32*QP+d0*16+hi*8]);
  float mhat=0.f,l_reg=0.f;f32x16 o[2];o[0]=f32x16{};o[1]=f32x16{};f32x16 negm=f32x16{};
  if constexpr(FIX){ mhat=mfix; _Pragma("unroll") for(int r=0;r<16;++r)negm[r]=-mfix; }
  asm volatile("":"+v"(negm));
  const int qrel=wid*QBLK+r32;
  #define CMASK(P0,P1,t) do{}while(0)
  bool resc=false;
  #define START(P0,P1) do{ resc=false; \
    if constexpr(!FIX){ const float rm=rowmax(P0,P1); const float dl=rm; mhat=fadd_s(mhat,dl); \
      _Pragma("unroll") for(int r=0;r<16;++r){P0[r]=fsub_s(P0[r],dl);P1[r]=fsub_s(P1[r],dl);} \
      _Pragma("unroll") for(int r=0;r<16;++r)negm[r]=-mhat; asm volatile("":"+v"(negm)); } \
    _Pragma("unroll") for(int r=0;r<16;++r)P0[r]=__builtin_amdgcn_exp2f(P0[r]); }while(0)
  #define RESC() do{ if(resc){ asm volatile("s_waitcnt lgkmcnt(0)":::"memory"); \
      _Pragma("unroll") for(int d_=0;d_<2;++d_) _Pragma("unroll") for(int r=0;r<16;++r)o[d_][r]*=wsf[crow(r,hi)]; } }while(0)
  f32x16 pA0,pA1,pB0,pB1;
  int sl_prev=0,sl_cur=0,sl_next=SLOTB;
  #define ROT() do{sl_prev=sl_cur;sl_cur=sl_next;sl_next=(sl_next==(NSLOT-1)*SLOTB)?0:sl_next+SLOTB;}while(0)
  DMA_K(2,2*SLOTB);
  WAIT_BAR(3);
  qkt(pA0,pA1,Kbase,qr,negm,r32,hi);asm volatile("s_nop 15\n\ts_nop 7":"+v"(pA0),"+v"(pA1));CMASK(pA0,pA1,0);
  START(pA0,pA1);
  _Pragma("unroll") for(int r=0;r<16;++r)pA1[r]=__builtin_amdgcn_exp2f(pA1[r]);
  WAIT_BAR(0);
  DMA_K(3,0);DMA_V(1,SLOTB);
  ROT();
  kload8(kf,kp0+sl_cur);
  WAIT_BAR(2);
  s16x4 vlo[8],vhi[8]; u32x4 pw0,pw1,pw2,pw3;
  #define PKW(P,B) cvtpk_s(P[B],P[B+1])
  #define PAF(k) __builtin_bit_cast(bf16x8,pw##k)
  #define VFR(i) (bf16x8){vlo[i][0],vlo[i][1],vlo[i][2],vlo[i][3],vhi[i][0],vhi[i][1],vhi[i][2],vhi[i][3]}
  #define PIN(x) asm volatile("":"+v"(x))
  #define MX3(a,b,c) __builtin_fmaxf(__builtin_fmaxf((a),(b)),(c))
  #define GAPA(MF,A0,A1,A2,A3,W0,W1,PW) do{ MF; sacc+=A0; sacc+=A1; sacc+=A2; sacc+=A3; PIN(sacc); W0; W1; PIN(PW); SBAR(); }while(0)
  #define EX(v) __builtin_amdgcn_exp2f(v)
  #define GAPB(MF,X,B) do{ MF; X[B]=EX(X[B]); X[B+1]=EX(X[B+1]); X[B+2]=EX(X[B+2]); X[B+3]=EX(X[B+3]); PIN(X); SBAR(); }while(0)
  #define VRD(i) do{ vlo[i]=vtr(vp_+(((i)>>2)*4096+((i)&3)*1024)); vhi[i]=vtr(vp_+(((i)>>2)*4096+((i)&3)*1024+512)); }while(0)
  #define KRD(G,j) do{ if(G){ kload2(kf,kp0+sl_next,j); SBAR(); } }while(0)
  #define STEP(C0,C1,P0,P1,t,GK,GV,GL) do{ SBAR(); \
    const lds_cptr vp_=vp0+sl_prev; \
    VRD(0); SBAR(); float sacc=(P0[0]+P0[1]); \
    GAPA(C0=__builtin_amdgcn_mfma_f32_32x32x16_bf16(kf[0],qr[0],negm,0,0,0), P0[2],P0[3],P0[4],P0[5],     pw0[0]=PKW(P0,0), pw0[1]=PKW(P0,2), pw0); \
    VRD(4); SBAR(); GAPA(C1=__builtin_amdgcn_mfma_f32_32x32x16_bf16(kf[1],qr[0],negm,0,0,0), P0[6],P0[7],P0[8],P0[9],     pw0[2]=PKW(P0,4), pw0[3]=PKW(P0,6), pw0); \
    VRD(1); SBAR(); GAPA(C0=__builtin_amdgcn_mfma_f32_32x32x16_bf16(kf[2],qr[1],C0,0,0,0),   P0[10],P0[11],P0[12],P0[13], pw1[0]=PKW(P0,8), pw1[1]=PKW(P0,10), pw1); \
    VRD(5); SBAR(); GAPA(C1=__builtin_amdgcn_mfma_f32_32x32x16_bf16(kf[3],qr[1],C1,0,0,0),   P0[14],P0[15],P1[0],P1[1],   pw1[2]=PKW(P0,12),pw1[3]=PKW(P0,14), pw1); \
    VRD(2); SBAR(); GAPA(C0=__builtin_amdgcn_mfma_f32_32x32x16_bf16(kf[4],qr[2],C0,0,0,0),   P1[2],P1[3],P1[4],P1[5],     pw2[0]=PKW(P1,0), pw2[1]=PKW(P1,2), pw2); \
    VRD(6); SBAR(); GAPA(C1=__builtin_amdgcn_mfma_f32_32x32x16_bf16(kf[5],qr[2],C1,0,0,0),   P1[6],P1[7],P1[8],P1[9],     pw2[2]=PKW(P1,4), pw2[3]=PKW(P1,6), pw2); \
    VRD(3); SBAR(); GAPA(C0=__builtin_amdgcn_mfma_f32_32x32x16_bf16(kf[6],qr[3],C0,0,0,0),   P1[10],P1[11],P1[12],P1[13], pw3[0]=PKW(P1,8), pw3[1]=PKW(P1,10), pw3); \
    VRD(7); SBAR(); GAPA(C1=__builtin_amdgcn_mfma_f32_32x32x16_bf16(kf[7],qr[3],C1,0,0,0),   P1[14],P1[15],0.f,0.f,       pw3[2]=PKW(P1,12),pw3[3]=PKW(P1,14), pw3); \
    l_reg+=sacc; \
    if(GK){DMA_K((t)+3,sl_cur);} if(GV){DMA_V((t)+1,sl_next);} \
    CMASK(C0,C1,t); \
    if constexpr(!FIX){ float a=MX3(C0[0],C0[1],C1[0]),b=MX3(C0[2],C0[3],C1[1]); a=MX3(a,C1[2],C1[3]); \
      _Pragma("unroll") for(int r=4;r<16;r+=4){a=MX3(a,C0[r],C0[r+1]);b=MX3(b,C0[r+2],C0[r+3]);a=MX3(a,C1[r],C1[r+1]);b=MX3(b,C1[r+2],C1[r+3]);} \
      float rm=__builtin_fmaxf(a,b); { auto rr=__builtin_amdgcn_permlane32_swap(__float_as_uint(rm),__float_as_uint(rm),false,false); rm=__builtin_fmaxf(__uint_as_float(rr[0]),__uint_as_float(rr[1])); } \
      resc=false; \
      if(__builtin_expect(__any(rm>(float)THRL),0)){ const float dl=__builtin_fmaxf(rm,0.f); mhat+=dl; \
        _Pragma("unroll") for(int r=0;r<16;++r){C0[r]-=dl;C1[r]-=dl;} \
        _Pragma("unroll") for(int r=0;r<16;++r)negm[r]=-mhat; asm volatile("":"+v"(negm)); \
        const float f=__builtin_amdgcn_exp2f(-dl); l_reg*=f; if(hi==0)wsf[r32]=f; resc=true; } } \
    SBAR(); \
    GAPB(o[0]=__builtin_amdgcn_mfma_f32_32x32x16_bf16(PAF(0),VFR(0),o[0],0,0,0), C0,0); \
    GAPB(o[1]=__builtin_amdgcn_mfma_f32_32x32x16_bf16(PAF(0),VFR(4),o[1],0,0,0), C0,4); \
    KRD(GL,0); GAPB(o[0]=__builtin_amdgcn_mfma_f32_32x32x16_bf16(PAF(1),VFR(1),o[0],0,0,0), C0,8); \
    KRD(GL,1); GAPB(o[1]=__builtin_amdgcn_mfma_f32_32x32x16_bf16(PAF(1),VFR(5),o[1],0,0,0), C0,12); \
    KRD(GL,2); GAPB(o[0]=__builtin_amdgcn_mfma_f32_32x32x16_bf16(PAF(2),VFR(2),o[0],0,0,0), C1,0); \
    KRD(GL,3); GAPB(o[1]=__builtin_amdgcn_mfma_f32_32x32x16_bf16(PAF(2),VFR(6),o[1],0,0,0), C1,4); \
    GAPB(o[0]=__builtin_amdgcn_mfma_f32_32x32x16_bf16(PAF(3),VFR(3),o[0],0,0,0), C1,8); \
    GAPB(o[1]=__builtin_amdgcn_mfma_f32_32x32x16_bf16(PAF(3),VFR(7),o[1],0,0,0), C1,12); \
    }while(0)
  int t=1;
  #undef CMASK
  #define CMASK(P0,P1,t) do{}while(0)
  for(;t+5<NT;t+=2){
    STEP(pB0,pB1,pA0,pA1,t,true,true,true);     WAIT_BAR(2); RESC(); ROT();
    STEP(pA0,pA1,pB0,pB1,t+1,true,true,true);   WAIT_BAR(2); RESC(); ROT();
  }
  #undef CMASK
  #define CMASK(P0,P1,t) do{}while(0)
  #define ENDW(tt) do{ if((tt)+3<NT){WAIT_BAR(2);} else if((tt)+2<NT){WAIT_BAR(1);} else {WAIT_BAR(0);} }while(0)
  for(;t+1<NT;t+=2){
    STEP(pB0,pB1,pA0,pA1,t,(t+3<NT),(t+1<NT),(t+1<NT));       ENDW(t);   RESC(); ROT();
    STEP(pA0,pA1,pB0,pB1,t+1,(t+4<NT),(t+2<NT),(t+2<NT));     ENDW(t+1); RESC(); ROT();
  }
  STEP(pB0,pB1,pA0,pA1,NT-1,false,false,false); RESC();
  { float sacc=pB0[0]+pB0[1]; _Pragma("unroll") for(int r=2;r<16;++r)sacc+=pB0[r]; _Pragma("unroll") for(int r=0;r<16;++r)sacc+=pB1[r]; l_reg+=sacc;
    pw0=(u32x4){PKW(pB0,0),PKW(pB0,2),PKW(pB0,4),PKW(pB0,6)};pw1=(u32x4){PKW(pB0,8),PKW(pB0,10),PKW(pB0,12),PKW(pB0,14)};pw2=(u32x4){PKW(pB1,0),PKW(pB1,2),PKW(pB1,4),PKW(pB1,6)};pw3=(u32x4){PKW(pB1,8),PKW(pB1,10),PKW(pB1,12),PKW(pB1,14)};
    SBAR(); pv(o,vb0+sl_cur,PAF(0),PAF(1),PAF(2),PAF(3)); }
  #undef PKW
  #undef PAF
  #undef VFR
  #undef PIN
  #undef MX3
  #undef GAPA
  #undef GAPB
  #undef EX
  #undef VRD
  #undef KRD
  #undef STEP
  #undef ENDW
  {auto rr=__builtin_amdgcn_permlane32_swap(__float_as_uint(l_reg),__float_as_uint(l_reg),false,false);l_reg=__uint_as_float(rr[0])+__uint_as_float(rr[1]);}
  if(hi==0)wsf[32+r32]=l_reg;asm volatile("s_waitcnt lgkmcnt(0)":::"memory");
  float rli[16];
  #pragma unroll
  for(int r=0;r<16;++r)rli[r]=__builtin_amdgcn_rcpf(wsf[32+crow(r,hi)]);
  const long orow0=(rowbase+q0+wid*QBLK)*OP+h*D; bf16*Ow=O+orow0; const bf16*Zw=Z+orow0;
  { bf16*stg=(bf16*)(shm+LDS_OST)+wid*2048;
    #pragma unroll
    for(int r=0;r<16;++r){const int orow=crow(r,hi);
      #pragma unroll
      for(int d0=0;d0<2;++d0)stg[orow*64+d0*32+r32]=__float2bfloat16(o[d0][r]*rli[r]);}
    asm volatile("s_waitcnt lgkmcnt(0)":::"memory");
    #pragma unroll
    for(int i=0;i<4;++i){const int row=i*8+(lane>>3),ch=lane&7; const u32x4 v=*(const u32x4*)(stg+row*64+ch*8); const u32x4 z=*(const u32x4*)(Zw+(long)row*OP+ch*8);
      u32x4 w; w.x=cvtpk_s(__uint_as_float(v.x<<16)*__uint_as_float(z.x<<16),__uint_as_float(v.x&0xffff0000u)*__uint_as_float(z.x&0xffff0000u));
      w.y=cvtpk_s(__uint_as_float(v.y<<16)*__uint_as_float(z.y<<16),__uint_as_float(v.y&0xffff0000u)*__uint_as_float(z.y&0xffff0000u));
      w.z=cvtpk_s(__uint_as_float(v.z<<16)*__uint_as_float(z.z<<16),__uint_as_float(v.z&0xffff0000u)*__uint_as_float(z.z&0xffff0000u));
      w.w=cvtpk_s(__uint_as_float(v.w<<16)*__uint_as_float(z.w<<16),__uint_as_float(v.w&0xffff0000u)*__uint_as_float(z.w&0xffff0000u));
      ATTN_STORE16(Ow+(long)row*OP+ch*8,w);} }
  asm volatile("s_waitcnt lgkmcnt(0)\n\ts_barrier":::"memory");
  #undef DMA_K
  #undef DMA_V
  #undef CMASK
  #undef START
  #undef RESC
  #undef ROT
}
constexpr int ATTN_LDS_BYTES=LDS_BYTES;
struct AttnTensors { const bf16* Q; const bf16* K; const bf16* V; const bf16* Z; bf16* O; };
template<int THRL,bool FIX> __device__ __forceinline__ void attn_phase(char*lds,const AttnTensors&T,int vcu,int G,float mfix){
  for(int u=vcu;u<1024;u+=G){ const int un=(G==256)?((vcu<<2)+((u-vcu)>>8)):u;
    attn_unit<THRL,FIX>(mfix,un>>6,(un>>3)&7,un&7,T.Q,T.K,T.V,T.Z,T.O,lds); }
}
#undef SBAR
#undef WAIT_BAR
}
constexpr int NWAVES = 8;
constexpr int BATCH = 16, SEQ = 2048, DM = 1024, CTX = 256, DIN = 2816, DCONV = 512;
constexpr int M = BATCH * SEQ;
constexpr int MC = BATCH * CTX;
constexpr size_t MiB = 1u << 20;
constexpr size_t WS_MOD = 0, WS_ROPE = 1 * MiB, WS_WIN = 2 * MiB, WS_WPW = 8 * MiB, WS_WOUT = 9 * MiB, WS_U = 16 * MiB, WS_Q = 88 * MiB, WS_KA = 120 * MiB, WS_VA = 130 * MiB,
                 WS_CTL = 12 * MiB, WS_Z = 140 * MiB, WS_UG = 204 * MiB, WS_Y = 236 * MiB, WS_MIX = 268 * MiB, WS_END = 332 * MiB;
constexpr size_t CTL_ZERO_BYTES = 16384;
constexpr int RING_BYTES = 131072, MISC_OFF = RING_BYTES + 320, LDS_BYTES = 147456;
#define LAS __attribute__((address_space(3)))
typedef unsigned short bf16;
typedef unsigned v4u __attribute__((ext_vector_type(4)));
typedef float f32x4 __attribute__((ext_vector_type(4)));
typedef float f32x2 __attribute__((ext_vector_type(2)));
#define LDS_WAIT() asm volatile("s_waitcnt lgkmcnt(0)" ::: "memory")
__device__ __forceinline__ unsigned pk2(float lo, float hi) { return pg8::cvt_pk_bf16(lo, hi); }
__device__ __forceinline__ float wave_sum(float v) {
#pragma unroll
    for (int o = 1; o < 64; o <<= 1) v += __shfl_xor(v, o);
    return v;
}
#define GAS __attribute__((address_space(1)))
#define RLX_AGENT __ATOMIC_RELAXED, __HIP_MEMORY_SCOPE_AGENT
#define XB_TMO      128
#define XB_XCNT(j)  (256  + 64 * (j))
#define XB_XSUB(j)  (1280 + 64 * (j))
#define XB_XGEN(j)  (2304 + 64 * (j))
#define XB_TOP      3328
#define XB_TOPGEN   3392
#define XCD_BAR_WORDS 3456
#define XB_SPIN_CAP (1u << 18)

__device__ __forceinline__ unsigned xb_ld(unsigned* p)              { return __hip_atomic_load(p, __ATOMIC_RELAXED, __HIP_MEMORY_SCOPE_AGENT); }
__device__ __forceinline__ unsigned xb_add(unsigned* p, unsigned v) { return __hip_atomic_fetch_add(p, v, __ATOMIC_RELAXED, __HIP_MEMORY_SCOPE_AGENT); }
__device__ __forceinline__ unsigned xb_xcc_id() { return (unsigned)__builtin_amdgcn_s_getreg((3 << 11) | 20) & 0xFu; }
#define XB_SPIN(cond, bar) do { unsigned _sp = 0; while (cond) { __builtin_amdgcn_s_sleep(1); \
    if ((++_sp & 255u) == 0u) { if (xb_ld(&(bar)[XB_TMO])) break; if (_sp > XB_SPIN_CAP) { atomicAdd(&(bar)[XB_TMO], 1u); break; } } } } while (0)

struct XcdBarrier {
    unsigned* bar; unsigned x;
    volatile LAS unsigned* st;
};

__device__ __forceinline__ XcdBarrier xcd_barrier_post(unsigned* bar, volatile LAS unsigned* st) {
    XcdBarrier b; b.bar = bar; b.x = xb_xcc_id(); b.st = st;
    if (threadIdx.x == 0) (void)xb_add(&bar[XB_XCNT(b.x)], 1u);
    return b;
}
__device__ __forceinline__ void xcd_barrier_complete(unsigned* bar, unsigned x, unsigned& nloc, unsigned& nx) {
    const unsigned G = gridDim.x * gridDim.y * gridDim.z;
    unsigned sum, cnt, mine, sp = 0u;
    for (;;) {
        sum = 0u; cnt = 0u; mine = 0u;
#pragma unroll
        for (unsigned j = 0; j < 16; ++j) { const unsigned c = xb_ld(&bar[XB_XCNT(j)]); sum += c; cnt += (c > 0u) ? 1u : 0u; mine = (j == x) ? c : mine; }
        if (sum == G) break;
        __builtin_amdgcn_s_sleep(1);
        if ((++sp & 255u) == 0u) { if (xb_ld(&bar[XB_TMO])) break; if (sp > XB_SPIN_CAP) { atomicAdd(&bar[XB_TMO], 1u); break; } }
    }
    nloc = mine > 0u ? mine : 1u; nx = cnt > 0u ? cnt : 1u;
}

__device__ __forceinline__ void xcd_barrier(const XcdBarrier& b) {
    asm volatile("s_waitcnt vmcnt(0)" ::: "memory");
    __syncthreads();
    if (threadIdx.x == 0) {
        unsigned* bar = b.bar;
        __builtin_amdgcn_s_waitcnt(0);
        unsigned nloc = b.st[0], nx = b.st[1];
        if (nloc == 0u) { xcd_barrier_complete(bar, b.x, nloc, nx); b.st[0] = nloc; b.st[1] = nx; }
        const unsigned old = xb_add(&bar[XB_XSUB(b.x)], 1u);
        const unsigned gen = old / nloc;
        if (old + 1u == (gen + 1u) * nloc) {
            __builtin_amdgcn_fence(__ATOMIC_RELEASE, "agent");
            asm volatile("s_waitcnt vmcnt(0)" ::: "memory");
            const unsigned og = xb_add(&bar[XB_TOP], 1u);
            const unsigned tg = og / nx;
            if (og + 1u == (tg + 1u) * nx) xb_add(&bar[XB_TOPGEN], 1u);
            else XB_SPIN(xb_ld(&bar[XB_TOPGEN]) == tg, bar);
            __builtin_amdgcn_fence(__ATOMIC_ACQUIRE, "agent");
            xb_add(&bar[XB_XGEN(b.x)], 1u);
            asm volatile("s_waitcnt vmcnt(0)" ::: "memory");
        } else {
            XB_SPIN(xb_ld(&bar[XB_XGEN(b.x)]) == gen, bar);
            __builtin_amdgcn_fence(__ATOMIC_ACQUIRE, "agent");
            asm volatile("s_waitcnt vmcnt(0)" ::: "memory");
        }
    }
    __syncthreads();
}
__device__ __forceinline__ int lmap_in(int P) {
    if (P < 768) { const int tile = P >> 8, p = P & 255, bj = p >> 7, wc = (p >> 5) & 3, j = p & 31; return tile * 256 + wc * 64 + ((j < 16) ? j : j + 16) + 16 * bj; }
    if (P >= 1280 && P < 2304) { const int q = P - 1280, T = q >> 8, p = q & 255; return (p < 128) ? (1280 + 128 * T + p) : (1792 + 128 * T + (p - 128)); }
    return P;
}
template <bool MAP> __device__ __forceinline__ void p0_transpose_item(const float* W, int K, int N, bf16* WT, LAS float* scr, int item, int lane) {
    const int nblk = N / 32, kb = item / nblk, nb = item % nblk, k0 = 64 * kb, n0 = 32 * nb;
    const int ncol = MAP ? lmap_in(n0 + (lane & 31)) : (n0 + (lane & 31));
#pragma unroll 8
    for (int i = 0; i < 32; ++i) { const int kk = 2 * i + (lane >> 5); scr[kk * 33 + (lane & 31)] = W[(size_t)(k0 + kk) * N + ncol]; }
    LDS_WAIT(); asm volatile("" ::: "memory");
    const int c = lane & 7;
#pragma unroll
    for (int j = 0; j < 4; ++j) { const int n = (lane >> 3) + 8 * j; const LAS float* s = scr + (8 * c) * 33 + n;
        v4u o; o.x = pk2(s[0 * 33], s[1 * 33]); o.y = pk2(s[2 * 33], s[3 * 33]); o.z = pk2(s[4 * 33], s[5 * 33]); o.w = pk2(s[6 * 33], s[7 * 33]);
        *(v4u*)(WT + (size_t)(n0 + n) * K + k0 + 8 * c) = o; }
    LDS_WAIT(); asm volatile("" ::: "memory");
}
__device__ __forceinline__ void mod_item(LAS unsigned char* lds, const float* c, const float* cctx, const float* wmod, const float* bmod, float* MOD, int nc, int tid) {
    LAS float* sc = (LAS float*)lds;
    LAS float* part = sc + 17 * 1024;
    const int w = tid >> 6, lane = tid & 63, col = lane & 15, kq = lane >> 4, n = nc * 16 + col, kbase = 128 * w + 32 * kq;
    float wv[32];
#pragma unroll
    for (int i = 0; i < 32; ++i) wv[i] = wmod[(size_t)(kbase + i) * 3072 + n];
    for (int idx = tid; idx < 17 * 1024; idx += 512) { const int r = idx >> 10, k = idx & 1023; const float v = (r < 16) ? c[r * 1024 + k] : cctx[k]; sc[idx] = pg8::silu_f(v); }
    __syncthreads();
    float acc[17];
#pragma unroll
    for (int r = 0; r < 17; ++r) acc[r] = 0.f;
#pragma unroll
    for (int i = 0; i < 32; ++i) {
#pragma unroll
        for (int r = 0; r < 17; ++r) acc[r] += sc[r * 1024 + kbase + i] * wv[i]; }
#pragma unroll
    for (int r = 0; r < 17; ++r) part[((w * 4 + kq) * 17 + r) * 16 + col] = acc[r];
    __syncthreads();
    for (int idx = tid; idx < 17 * 16; idx += 512) { const int r = idx >> 4, l = idx & 15; float sum = bmod[nc * 16 + l];
#pragma unroll
        for (int p = 0; p < 32; ++p) sum += part[(p * 17 + r) * 16 + l];
        MOD[(size_t)r * 3072 + nc * 16 + l] = sum; }
    __syncthreads();
}
__device__ __forceinline__ void p1_rows(const float* x, const float* ctx, const float* normw, const float* MOD, bf16* U, int gw, int NGW, int lane) {
    for (int ch = gw; ch < (M + MC) / 4; ch += NGW) {
        const int row0 = 4 * ch; const bool isc = row0 >= M; const int b = isc ? 16 : (row0 >> 11);
        const float* src = isc ? ctx + (size_t)(row0 - M) * DM : x + (size_t)row0 * DM;
        const float* mp = MOD + (size_t)b * 3072;
        f32x4 g[4], sh[4];
#pragma unroll
        for (int j = 0; j < 4; ++j) { const int col = 4 * lane + 256 * j; const f32x4 nw = *(const f32x4*)(normw + col), scl = *(const f32x4*)(mp + 1024 + col); sh[j] = *(const f32x4*)(mp + col); g[j] = nw * (1.0f + scl); }
        f32x4 vv[4][4];
#pragma unroll
        for (int rr = 0; rr < 4; ++rr) { const f32x4* xr = (const f32x4*)(src + (size_t)rr * DM) + lane;
#pragma unroll
            for (int j = 0; j < 4; ++j) vv[rr][j] = __builtin_nontemporal_load(xr + 64 * j); }
        asm volatile("" ::: "memory");
#pragma unroll
        for (int rr = 0; rr < 4; ++rr) {
            f32x4 v[4]; float s = 0.f;
#pragma unroll
            for (int j = 0; j < 4; ++j) { v[j] = vv[rr][j]; s += (v[j].x * v[j].x + v[j].y * v[j].y) + (v[j].z * v[j].z + v[j].w * v[j].w); }
            const float rinv = rsqrtf(wave_sum(s) * (1.0f / DM) + 1e-6f);
            unsigned long long* o8 = (unsigned long long*)(U + (size_t)(row0 + rr) * DM) + lane;
#pragma unroll
            for (int j = 0; j < 4; ++j) { const f32x4 o = v[j] * rinv * g[j] + sh[j];
                o8[64 * j] = (unsigned long long)pk2(o.x, o.y) | ((unsigned long long)pk2(o.z, o.w) << 32); }
        }
    }
}
__device__ __forceinline__ void conv_phase(LAS unsigned char* lds, const bf16* UG, const float* cw, const float* cb, const float* lnw, const float* lnb, bf16* Y, int vcu, int G, int tid) {
    LAS float* tile = (LAS float*)lds;
    const int cp = tid & 255, th = tid >> 8, wv = tid >> 6, lane = tid & 63;
    f32x2 w[31];
#pragma unroll
    for (int j = 0; j < 31; ++j) w[j] = *(const f32x2*)(cw + j * 512 + 2 * cp);
    const f32x2 bias = *(const f32x2*)(cb + 2 * cp);
    for (int item = vcu; item < M / 32; item += G) {
        const int row0 = item * 32 + th * 16, t0 = row0 & 2047;
        const unsigned* ub = (const unsigned*)(UG + (size_t)(row0 - t0) * 512 + 2 * cp);
        unsigned xr[46];
#pragma unroll
        for (int r = 0; r < 46; ++r) { const int tin = t0 - 15 + r, tc = tin < 0 ? 0 : (tin > 2047 ? 2047 : tin); xr[r] = ub[(size_t)tc * 256]; }
        f32x2 acc[16];
#pragma unroll
        for (int i = 0; i < 16; ++i) acc[i] = (f32x2){0.f, 0.f};
#pragma unroll
        for (int r = 0; r < 46; ++r) {
            const int tin = t0 - 15 + r; const bool ok = (tin >= 0) && (tin < 2048);
            const f32x2 xv = (f32x2){ok ? pg8::bf_lo(xr[r]) : 0.f, ok ? pg8::bf_hi(xr[r]) : 0.f};
#pragma unroll
            for (int i = 0; i < 16; ++i) { const int j = r - i; if (j >= 0 && j <= 30) acc[i] += xv * w[j]; }
        }
#pragma unroll
        for (int i = 0; i < 16; ++i) *(LAS f32x2*)(tile + (th * 16 + i) * 512 + 2 * cp) = acc[i] + bias;
        __syncthreads();
        const f32x4 lw0 = *(const f32x4*)(lnw + 8 * lane), lw1 = *(const f32x4*)(lnw + 8 * lane + 4), lb0 = *(const f32x4*)(lnb + 8 * lane), lb1 = *(const f32x4*)(lnb + 8 * lane + 4);
#pragma unroll
        for (int rr = 0; rr < 4; ++rr) {
            const int row = 4 * wv + rr;
            const f32x4 a = *(const LAS f32x4*)(tile + row * 512 + 8 * lane), b = *(const LAS f32x4*)(tile + row * 512 + 8 * lane + 4);
            const float mean = wave_sum((a.x + a.y) + (a.z + a.w) + (b.x + b.y) + (b.z + b.w)) * (1.0f / 512.0f);
            const f32x4 da = a - mean, db = b - mean;
            const float var = wave_sum((da.x * da.x + da.y * da.y) + (da.z * da.z + da.w * da.w) + (db.x * db.x + db.y * db.y) + (db.z * db.z + db.w * db.w)) * (1.0f / 512.0f);
            const float rstd = rsqrtf(var + 1e-6f);
            const f32x4 ya = da * rstd * lw0 + lb0, yb = db * rstd * lw1 + lb1;
            v4u o; o.x = pk2(pg8::silu_f(ya.x), pg8::silu_f(ya.y)); o.y = pk2(pg8::silu_f(ya.z), pg8::silu_f(ya.w)); o.z = pk2(pg8::silu_f(yb.x), pg8::silu_f(yb.y)); o.w = pk2(pg8::silu_f(yb.z), pg8::silu_f(yb.w));
            *(v4u*)(Y + (size_t)(item * 32 + row) * 512 + 8 * lane) = o;
        }
        __syncthreads();
    }
}

#ifndef MK_N_LAUNCHES
#define MK_N_LAUNCHES 1
#endif
constexpr int N_PHASES = 6;
struct Args { const float* in[17]; float* out; unsigned char* ws; int ph_lo, ph_hi; };
__global__ void __launch_bounds__(NWAVES * 64, 2) hybrid_fwd(Args args) {
    extern __shared__ __attribute__((aligned(16))) unsigned char lds[];
    LAS unsigned char* ldsl = (LAS unsigned char*)lds;
    const int tid = threadIdx.x, lane = tid & 63, wave = __builtin_amdgcn_readfirstlane(tid >> 6);
    const int G = gridDim.x, bx = blockIdx.x, vcu = (G % 8 == 0) ? (bx % 8) * (G / 8) + bx / 8 : bx;
    const int gw = vcu * NWAVES + wave, NGW = G * NWAVES;
    unsigned char* ws = args.ws;
    const float *x = args.in[0], *cvec = args.in[1], *ctx = args.in[2], *cctx = args.in[3], *wmod = args.in[4], *bmod = args.in[5], *normw = args.in[6], *win = args.in[7],
                *qnw = args.in[8], *knw = args.in[9], *convw = args.in[10], *convb = args.in[11], *lnw = args.in[12], *lnb = args.in[13], *wpw = args.in[14], *bpw = args.in[15], *wout = args.in[16];
    float* MOD = (float*)(ws + WS_MOD); float* ROPE = (float*)(ws + WS_ROPE);
    bf16 *WIN_T = (bf16*)(ws + WS_WIN), *WPW_T = (bf16*)(ws + WS_WPW), *WOUT_T = (bf16*)(ws + WS_WOUT), *U = (bf16*)(ws + WS_U), *Q = (bf16*)(ws + WS_Q), *KA = (bf16*)(ws + WS_KA), *VA = (bf16*)(ws + WS_VA),
         *Z = (bf16*)(ws + WS_Z), *UG = (bf16*)(ws + WS_UG), *Y = (bf16*)(ws + WS_Y), *MIX = (bf16*)(ws + WS_MIX);
    const int lo = args.ph_lo, hi = args.ph_hi;
#define IN(k) (lo <= (k) && (k) < hi)
    for (int u = tid; u < (LDS_BYTES - RING_BYTES) / 4; u += NWAVES * 64) ((LAS unsigned*)(ldsl + RING_BYTES))[u] = 0u;
    __syncthreads();
    XcdBarrier bar; bar.bar = (unsigned*)(ws + WS_CTL); bar.x = 0; bar.st = nullptr;
    if (hi - lo > 1) bar = xcd_barrier_post((unsigned*)(ws + WS_CTL), (volatile LAS unsigned*)(ldsl + MISC_OFF) + 8);
    if (lo > 99) cooperative_groups::this_grid().sync();
#define SEAM(k) do { if (IN(k) && IN((k) + 1)) xcd_barrier(bar); } while (0)
#ifndef REPMASK
#define REPMASK 0
#endif
#define REPS(k) for (int rep_ = 0; rep_ < 1 + ((REPMASK >> (k)) & 1); ++rep_)

    if (IN(0)) REPS(0) {
        LAS float* scr = (LAS float*)(ldsl + wave * 16384);
        constexpr int I_IN = (DM / 64) * (DIN / 32), I_PW = (DCONV / 64) * (DCONV / 32), I_OUT = (DM / 64) * (DM / 32);
        for (int it = gw; it < I_IN + I_PW + I_OUT; it += NGW) {
            int r = it;
            if (r < I_IN) { p0_transpose_item<true>(win, DM, DIN, WIN_T, scr, r, lane); continue; } r -= I_IN;
            if (r < I_PW) { p0_transpose_item<false>(wpw, DCONV, DCONV, WPW_T, scr, r, lane); continue; } r -= I_PW;
            p0_transpose_item<false>(wout, DM, DM, WOUT_T, scr, r, lane);
        }
        { const int gt = bx * 512 + tid;
          if (gt < 1024) { const int pos = gt >> 4, f = gt & 15; const float freq = powf(10000.0f, -(float)f * (1.0f / 16.0f)); const float ang = (float)pos * freq;
              ROPE[2 * gt] = cosf(ang); ROPE[2 * gt + 1] = sinf(ang); } }
        __syncthreads();
        for (int nc = bx; nc < 192; nc += G) mod_item(ldsl, cvec, cctx, wmod, bmod, MOD, nc, tid);
    }
    SEAM(0);
    if (IN(1)) REPS(1) p1_rows(x, ctx, normw, MOD, U, gw, NGW, lane);
    SEAM(1);
    if (IN(2)) REPS(2) {
        pg8::Gemm g{U, WIN_T, M + MC, DIN, DM}; pg8::OrderIn S; S.init(G, bx);
        pg8::EpiIn E{Q, KA, VA, Z, UG, ROPE, qnw, knw};
        pg8::gemm_phase<pg8::EpiIn, pg8::OrderIn, true, true>(ldsl, g, S, E);
    }
    SEAM(2);
    if (IN(3)) REPS(3) conv_phase(ldsl, UG, convw, convb, lnw, lnb, Y, vcu, G, tid);
    SEAM(3);
    if (IN(4)) REPS(4) {
        const attn_body::AttnTensors AT{(const attn_body::bf16*)Q, (const attn_body::bf16*)KA, (const attn_body::bf16*)VA, (const attn_body::bf16*)Z, (attn_body::bf16*)MIX};
        float mq = 0.f, mk = 0.f;
        for (int d = 0; d < 64; ++d) { mq = fmaxf(mq, fabsf(qnw[d])); mk = fmaxf(mk, fabsf(knw[d])); }
        const float mfix = 1.02f * 64.0f * pg8::QC2 * mq * mk;
        if (mfix <= 60.0f) attn_body::attn_phase<8, true>((char*)lds, AT, vcu, G, mfix);
        else               attn_body::attn_phase<8, false>((char*)lds, AT, vcu, G, 0.f);
        pg8::Gemm g{Y, WPW_T, M, DCONV, DCONV}; pg8::StaticOrder S; S.init(M, DCONV, G, bx);
        pg8::EpiPw E{Z, MIX, bpw};
        pg8::gemm_phase<pg8::EpiPw, pg8::StaticOrder, true, true>(ldsl, g, S, E);
    }
    SEAM(4);
    if (IN(5)) REPS(5) {
        pg8::Gemm g{MIX, WOUT_T, M, DM, DM}; pg8::StaticOrder S; S.init(M, DM, G, bx);
        pg8::EpiOut E{x, args.out, MOD};
        pg8::gemm_phase<pg8::EpiOut, pg8::StaticOrder, true, true>(ldsl, g, S, E);
    }
#undef IN
#undef SEAM
}

extern "C" void kernel_launch(void* const* d_in, const int* in_sizes, int n_in, void* d_out, int out_size, void* d_ws, size_t ws_size, hipStream_t stream) {
    static int grid = 0;
    if (grid == 0) {
        if (n_in != 17 || in_sizes[0] != M * DM || out_size != M * DM || ws_size < WS_END) { fprintf(stderr, "kernel_launch: unexpected shapes (n_in %d, in0 %d, out %d, ws %zu); nothing launched\n", n_in, n_in > 0 ? in_sizes[0] : -1, out_size, ws_size); grid = -1; return; }
        int dev = 0, cus = 0, per_cu = 0;
        if (hipGetDevice(&dev) != hipSuccess || hipDeviceGetAttribute(&cus, hipDeviceAttributeMultiprocessorCount, dev) != hipSuccess) { grid = -1; return; }
        if (hipFuncSetAttribute((const void*)hybrid_fwd, hipFuncAttributeMaxDynamicSharedMemorySize, LDS_BYTES) != hipSuccess) { fprintf(stderr, "kernel_launch: hipFuncSetAttribute failed\n"); grid = -1; return; }
        if (hipOccupancyMaxActiveBlocksPerMultiprocessor(&per_cu, (const void*)hybrid_fwd, NWAVES * 64, LDS_BYTES) != hipSuccess || per_cu < 1) { fprintf(stderr, "kernel_launch: occupancy query says %d\n", per_cu); per_cu = 1; }
        (void)hipGetLastError();
        grid = cus * per_cu;
    }
    if (grid < 0) return;
    if (hipMemsetAsync((char*)d_ws + WS_CTL, 0, CTL_ZERO_BYTES, stream) != hipSuccess) { fprintf(stderr, "kernel_launch: memset failed\n"); return; }
    Args a{};
    for (int i = 0; i < 17; ++i) a.in[i] = (const float*)d_in[i];
    a.out = (float*)d_out; a.ws = (unsigned char*)d_ws;
#if MK_N_LAUNCHES == 1
    a.ph_lo = 0; a.ph_hi = N_PHASES;
    void* kargs[] = {&a};
    hipError_t e = hipLaunchCooperativeKernel((const void*)hybrid_fwd, dim3(grid), dim3(NWAVES * 64), kargs, LDS_BYTES, stream);
    if (e != hipSuccess) fprintf(stderr, "kernel_launch: cooperative launch failed: %s (grid %d)\n", hipGetErrorString(e), grid);
#else
    for (int p = 0; p < N_PHASES; ++p) { a.ph_lo = p; a.ph_hi = p + 1; hipLaunchKernelGGL(hybrid_fwd, dim3(grid), dim3(NWAVES * 64), LDS_BYTES, stream, a); }
#endif
}
```

```cpp
#include <hip/hip_runtime.h>
#include <hip/hip_cooperative_groups.h>
#include <cstdio>
#include <cstdint>
namespace pg8 {
#define PG8_LAS __attribute__((address_space(3)))
typedef unsigned short bf16_t;
typedef short bf16x8 __attribute__((ext_vector_type(8)));
typedef float f32x4 __attribute__((ext_vector_type(4)));
typedef unsigned u32x4 __attribute__((ext_vector_type(4)));
constexpr int BM = 256, BK = 64, HALF = 128, HTB = HALF * BK * 2  , STAGE_BYTES = 8 * HTB, NXCD = 8, WGM = 8;

__host__ __device__ __forceinline__ int lds_byte(int r, int c) { const int st = (r >> 4) * 2 + (c >> 5), rr = r & 15, cc = c & 31, ob = rr * 64 + cc * 2; return st * 1024 + (ob ^ (((ob >> 9) & 1) << 5)); }
__host__ __device__ __forceinline__ void stage_rc(int b, int& R, int& C) { const int st = b / 1024, sb = b % 1024, swz = sb ^ (((sb >> 9) & 1) << 5); R = (st >> 1) * 16 + swz / 64; C = (st & 1) * 32 + (swz % 64) / 2; }
__host__ __device__ __forceinline__ int perm32(int rho) { const int n = rho >> 4, i = rho & 15; return 8 * (i >> 2) + 4 * n + (i & 3); }

struct Unit { int pm, pn; };
struct Gemm { const bf16_t* A; const bf16_t* Bt; int M, N, K; };

struct StaticOrder {
    int nM, nN, nwg, G, c;
    __host__ __device__ void init(int M, int N, int G_, int c_) { nM = M / BM; nN = N / BM; nwg = nM * nN; G = G_; c = c_; }
    __host__ __device__ bool next(int i, Unit& u) const {
        const long L = (long)i * G + c; if (L >= nwg) return false;
        int wgid = (int)L; { const int q = nwg / NXCD, r = nwg % NXCD, xcd = wgid % NXCD, off = wgid / NXCD; wgid = (xcd < r ? xcd * (q + 1) : r * (q + 1) + (xcd - r) * q) + off; }
        const int nig = WGM * nN, gid = wgid / nig, fm = gid * WGM, gsz = (nM - fm) < WGM ? (nM - fm) : WGM;
        u.pm = fm + ((wgid % nig) % gsz); u.pn = (wgid % nig) / gsz; return true;
    }
    __device__ __forceinline__ void a_ready(const Unit&) const {}
    __device__ __forceinline__ void done(const Unit&) const {}
};
__device__ __forceinline__ unsigned cvt_pk_bf16(float lo, float hi) { unsigned r; asm volatile("v_cvt_pk_bf16_f32 %0, %1, %2" : "=v"(r) : "v"(lo), "v"(hi)); return r; }
typedef float f32x2 __attribute__((ext_vector_type(2)));
constexpr float QC2 = 0.125f * 1.4426950408889634f;
__device__ __forceinline__ float silu_f(float v) { return v * __builtin_amdgcn_rcpf(1.0f + __expf(-v)); }
__device__ __forceinline__ float sigm_f(float v) { return __builtin_amdgcn_rcpf(1.0f + __expf(-v)); }
__device__ __forceinline__ float bf_lo(unsigned w) { return __uint_as_float(w << 16); }
__device__ __forceinline__ float bf_hi(unsigned w) { return __uint_as_float(w & 0xffff0000u); }

struct OrderIn {
    StaticOrder so;
    __device__ void init(int G_, int c_) { so.init(32768, 2816, G_, c_); }
    __device__ bool next(int i, Unit& u) const {
        const long L = (long)i * so.G + so.c;
        if (L < so.nwg) return so.next(i, u);
        const int e = (int)(L - so.nwg); if (e >= 16) return false;
        u.pm = 128 + e; u.pn = 2; return true;
    }
    __device__ __forceinline__ void a_ready(const Unit&) const {}
    __device__ __forceinline__ void done(const Unit&) const {}
};

struct EpiIn {
    static constexpr bool PERM = true, AFTER_DRAIN = false;
    bf16_t *Q, *KA, *VA, *Z, *UG; const float* rope; const float *qnw, *knw;
    __device__ __forceinline__ void operator()(const f32x4 (&acc)[2][2][4][2], const Unit& u, int wr, int wc, int fr, int fq) const {
        const int pn = u.pn;
        const int rowb = u.pm * BM + wr * 64 + fr;
        if (pn <= 2) {
            const bool isq = pn < 2, isv = (pn == 2) && (wc >= 2), isctx = u.pm >= 128;
            const int d1 = (fq & 1) * 8 + (fq >> 1) * 32;
            float w1[8], w2[8];
            { const float* nw = isq ? qnw : knw; const float sc = isq ? QC2 : 1.0f;
#pragma unroll
              for (int e = 0; e < 8; ++e) { w1[e] = nw[d1 + e] * sc; w2[e] = nw[d1 + 16 + e] * sc; } }
#pragma unroll
            for (int ai = 0; ai < 2; ++ai)
#pragma unroll
                for (int m = 0; m < 4; ++m) {
                    const int row = rowb + ai * HALF + m * 16;
                    float x1[8], x2[8];
#pragma unroll
                    for (int n = 0; n < 2; ++n)
#pragma unroll
                        for (int i = 0; i < 4; ++i) { x1[4 * n + i] = acc[ai][0][m][n][i]; x2[4 * n + i] = acc[ai][1][m][n][i]; }
                    bf16_t* dst;
                    if (isq) dst = Q + (size_t)row * 512 + (4 * pn + wc) * 64 + d1;
                    else {
                        size_t pos;
                        if (isctx) { const int r2 = row - 32768; pos = (size_t)(r2 >> 8) * 2304 + (r2 & 255); }
                        else pos = (size_t)(row >> 11) * 2304 + 256 + (row & 2047);
                        dst = (isv ? VA : KA) + pos * 128 + (wc & 1) * 64 + d1;
                    }
                    if (!isv) {
                        float ss = 0.f;
#pragma unroll
                        for (int e = 0; e < 8; ++e) ss += x1[e] * x1[e] + x2[e] * x2[e];
                        ss += __shfl_xor(ss, 16); ss += __shfl_xor(ss, 32);
                        const float rinv = rsqrtf(ss * (1.0f / 64.0f) + 1e-6f);
#pragma unroll
                        for (int e = 0; e < 8; ++e) { x1[e] = x1[e] * rinv * w1[e]; x2[e] = x2[e] * rinv * w2[e]; }
                        if (!isctx) {
                            const int t = row & 2047, pos = (fq >> 1) ? (t & 63) : (t >> 6);
                            const f32x4* rp = (const f32x4*)(rope + (size_t)(pos * 16 + (fq & 1) * 8) * 2);
#pragma unroll
                            for (int e2 = 0; e2 < 4; ++e2) { const f32x4 cs = rp[e2];
                                { const float a = x1[2 * e2], b = x2[2 * e2]; x1[2 * e2] = a * cs[0] - b * cs[1]; x2[2 * e2] = a * cs[1] + b * cs[0]; }
                                { const float a = x1[2 * e2 + 1], b = x2[2 * e2 + 1]; x1[2 * e2 + 1] = a * cs[2] - b * cs[3]; x2[2 * e2 + 1] = a * cs[3] + b * cs[2]; } }
                        }
                    }
                    u32x4 o1, o2;
                    o1.x = cvt_pk_bf16(x1[0], x1[1]); o1.y = cvt_pk_bf16(x1[2], x1[3]); o1.z = cvt_pk_bf16(x1[4], x1[5]); o1.w = cvt_pk_bf16(x1[6], x1[7]);
                    o2.x = cvt_pk_bf16(x2[0], x2[1]); o2.y = cvt_pk_bf16(x2[2], x2[3]); o2.z = cvt_pk_bf16(x2[4], x2[5]); o2.w = cvt_pk_bf16(x2[6], x2[7]);
                    *(u32x4*)dst = o1; *(u32x4*)(dst + 16) = o2;
                }
        } else if (pn >= 5 && pn <= 8) {
            const int c0 = (pn - 5) * 128 + wc * 32 + 8 * fq;
#pragma unroll
            for (int ai = 0; ai < 2; ++ai)
#pragma unroll
                for (int m = 0; m < 4; ++m) {
                    const int row = rowb + ai * HALF + m * 16;
                    const f32x4 a0 = acc[ai][0][m][0], a1 = acc[ai][0][m][1], g0 = acc[ai][1][m][0], g1 = acc[ai][1][m][1];
                    u32x4 w;
                    w.x = cvt_pk_bf16(a0[0] * sigm_f(g0[0]), a0[1] * sigm_f(g0[1])); w.y = cvt_pk_bf16(a0[2] * sigm_f(g0[2]), a0[3] * sigm_f(g0[3]));
                    w.z = cvt_pk_bf16(a1[0] * sigm_f(g1[0]), a1[1] * sigm_f(g1[1])); w.w = cvt_pk_bf16(a1[2] * sigm_f(g1[2]), a1[3] * sigm_f(g1[3]));
                    *(u32x4*)(UG + (size_t)row * 512 + c0) = w;
                }
        } else {
            const int zc = (pn <= 4 ? (pn - 3) * 256 : 512 + (pn - 9) * 256) + wc * 32 + 8 * fq;
#pragma unroll
            for (int ai = 0; ai < 2; ++ai)
#pragma unroll
                for (int m = 0; m < 4; ++m) {
                    const int row = rowb + ai * HALF + m * 16;
#pragma unroll
                    for (int bj = 0; bj < 2; ++bj) { const f32x4 v0 = acc[ai][bj][m][0], v1 = acc[ai][bj][m][1];
                        u32x4 w; w.x = cvt_pk_bf16(silu_f(v0[0]), silu_f(v0[1])); w.y = cvt_pk_bf16(silu_f(v0[2]), silu_f(v0[3]));
                        w.z = cvt_pk_bf16(silu_f(v1[0]), silu_f(v1[1])); w.w = cvt_pk_bf16(silu_f(v1[2]), silu_f(v1[3]));
                        *(u32x4*)(Z + (size_t)row * 1024 + zc + bj * HALF) = w; }
                }
        }
    }
};

struct EpiPw {
    static constexpr bool PERM = true, AFTER_DRAIN = false;
    const bf16_t* Z; bf16_t* MIX; const float* bias;
    __device__ __forceinline__ void operator()(const f32x4 (&acc)[2][2][4][2], const Unit& u, int wr, int wc, int fr, int fq) const {
        const int rowb = u.pm * BM + wr * 64 + fr, col0 = u.pn * BM + wc * 32 + 8 * fq;
        f32x4 bv[2][2];
#pragma unroll
        for (int bj = 0; bj < 2; ++bj)
#pragma unroll
            for (int n = 0; n < 2; ++n) bv[bj][n] = *(const f32x4*)(bias + col0 + bj * HALF + 4 * n);
        u32x4 zz[2][4][2];
#pragma unroll
        for (int ai = 0; ai < 2; ++ai)
#pragma unroll
            for (int m = 0; m < 4; ++m) { const size_t off = (size_t)(rowb + ai * HALF + m * 16) * 1024 + 512 + col0;
#pragma unroll
                for (int bj = 0; bj < 2; ++bj) zz[ai][m][bj] = *(const u32x4*)(Z + off + bj * HALF); }
        asm volatile("" ::: "memory");
#pragma unroll
        for (int ai = 0; ai < 2; ++ai)
#pragma unroll
            for (int m = 0; m < 4; ++m) {
                const size_t off = (size_t)(rowb + ai * HALF + m * 16) * 1024 + 512 + col0;
#pragma unroll
                for (int bj = 0; bj < 2; ++bj) {
                    const u32x4 z = zz[ai][m][bj];
                    const f32x4 v0 = acc[ai][bj][m][0] + bv[bj][0], v1 = acc[ai][bj][m][1] + bv[bj][1];
                    u32x4 w;
                    w.x = cvt_pk_bf16(v0[0] * bf_lo(z.x), v0[1] * bf_hi(z.x)); w.y = cvt_pk_bf16(v0[2] * bf_lo(z.y), v0[3] * bf_hi(z.y));
                    w.z = cvt_pk_bf16(v1[0] * bf_lo(z.z), v1[1] * bf_hi(z.z)); w.w = cvt_pk_bf16(v1[2] * bf_lo(z.w), v1[3] * bf_hi(z.w));
                    *(u32x4*)(MIX + off + bj * HALF) = w;
                }
            }
    }
};

struct EpiOut {
    static constexpr bool PERM = false, AFTER_DRAIN = false;
    const float* x; float* out; const float* mod;
    __device__ __forceinline__ void operator()(const f32x4 (&acc)[2][2][4][2], const Unit& u, int wr, int wc, int fr, int fq) const {
        const int rowb = u.pm * BM + wr * 64 + fr, col0 = u.pn * BM + wc * 32 + 4 * fq;
        const float* gp = mod + (size_t)(u.pm >> 3) * 3072 + 2048 + col0;
        f32x4 gv[2][2];
#pragma unroll
        for (int bj = 0; bj < 2; ++bj)
#pragma unroll
            for (int n = 0; n < 2; ++n) gv[bj][n] = *(const f32x4*)(gp + bj * HALF + n * 16);
        const float* __restrict__ xr_ = x; float* __restrict__ or_ = out;
#pragma unroll
        for (int ai = 0; ai < 2; ++ai) {
            f32x4 xv[4][2][2];
#pragma unroll
            for (int m = 0; m < 4; ++m) { const size_t off = (size_t)(rowb + ai * HALF + m * 16) * 1024 + col0;
#pragma unroll
                for (int bj = 0; bj < 2; ++bj)
#pragma unroll
                    for (int n = 0; n < 2; ++n) xv[m][bj][n] = *(const f32x4*)(xr_ + off + bj * HALF + n * 16); }
            asm volatile("" ::: "memory");
#pragma unroll
            for (int m = 0; m < 4; ++m) { const size_t off = (size_t)(rowb + ai * HALF + m * 16) * 1024 + col0;
#pragma unroll
                for (int bj = 0; bj < 2; ++bj)
#pragma unroll
                    for (int n = 0; n < 2; ++n) *(f32x4*)(or_ + off + bj * HALF + n * 16) = xv[m][bj][n] + gv[bj][n] * acc[ai][bj][m][n]; }
            asm volatile("" ::: "memory");
        }
    }
};
template <class Epi, class Sched, bool ALIGN_EPI = false, bool SP2 = false>
__device__ __forceinline__ void gemm_phase(PG8_LAS unsigned char* lds, const Gemm g, const Sched& S, const Epi& E) {
    const int tid = threadIdx.x, wid = __builtin_amdgcn_readfirstlane(tid >> 6), lane = tid & 63, wr = wid >> 2, wc = wid & 3, fr = lane & 15, fq = lane >> 4;
    const int K = g.K, nt = K / BK;
    unsigned voffA[2], voffB[2];
#pragma unroll
    for (int i = 0; i < 2; ++i) { int R, C; stage_rc(tid * 16 + i * 8192, R, C); const int Rb = Epi::PERM ? ((R & ~31) + perm32(R & 31)) : R;
        voffA[i] = (unsigned)(R * K + C) * 2u; voffB[i] = (unsigned)(Rb * K + C) * 2u; }
    const size_t kstep = (size_t)(BK * 2);
    const size_t hstep = (size_t)HALF * K * 2;
    const size_t tstep = 2 * hstep;
    const unsigned ldsw = (unsigned)wid * 1024u;
    const int aoff = lds_byte(wr * 64 + fr, fq * 8), boff = lds_byte(wc * 32 + fr, fq * 8);
#define PG8_SA(b, h) (((b) * 2 + (h)) * HTB)
#define PG8_SB(b, h) ((4 + (b) * 2 + (h)) * HTB)
#define PG8_STAGE(bufoff, gbase, voff) do { _Pragma("unroll") for (int _i = 0; _i < 2; ++_i) \
        __builtin_amdgcn_global_load_lds((const unsigned*)((const char*)(gbase) + (voff)[_i]), (PG8_LAS unsigned*)(lds + (bufoff) + ldsw + _i * 8192), 16, 0, 0); } while (0)
#define PG8_LDA(dst, b, h) do { _Pragma("unroll") for (int m = 0; m < 4; ++m) _Pragma("unroll") for (int k = 0; k < 2; ++k) dst[m][k] = *(const PG8_LAS bf16x8*)(lds + PG8_SA(b, h) + aoff + m * 2048 + k * 1024); } while (0)
#define PG8_LDB(dst, b, h) do { _Pragma("unroll") for (int n = 0; n < 2; ++n) _Pragma("unroll") for (int k = 0; k < 2; ++k) dst[n][k] = *(const PG8_LAS bf16x8*)(lds + PG8_SB(b, h) + boff + n * 2048 + k * 1024); } while (0)
#define PG8_MMA(ai, bj, At, Bt) do { __builtin_amdgcn_s_setprio(1); _Pragma("unroll") for (int m = 0; m < 4; ++m) _Pragma("unroll") for (int n = 0; n < 2; ++n) _Pragma("unroll") for (int k = 0; k < 2; ++k) \
        acc[ai][bj][m][n] = __builtin_amdgcn_mfma_f32_16x16x32_bf16(Bt[n][k], At[m][k], acc[ai][bj][m][n], 0, 0, 0); __builtin_amdgcn_s_setprio(0); } while (0)
#define PG8_WAIT_V(n) asm volatile("s_waitcnt vmcnt(" #n ")" ::: "memory")
#define PG8_WAIT_L(n) asm volatile("s_waitcnt lgkmcnt(" #n ")" ::: "memory")
#define PG8_BAR __builtin_amdgcn_s_barrier()
#define PG8_SCHED __builtin_amdgcn_sched_barrier(0)
    Unit cur, nxt; int ui = 0;
    if (!S.next(0, cur)) return;
    f32x4 acc[2][2][4][2];
#pragma unroll
    for (int a = 0; a < 2; ++a)
#pragma unroll
        for (int b = 0; b < 2; ++b)
#pragma unroll
            for (int m = 0; m < 4; ++m)
#pragma unroll
                for (int n = 0; n < 2; ++n) acc[a][b][m][n] = (f32x4){0.f, 0.f, 0.f, 0.f};
    bf16x8 At[4][2], B0[2][2], B1[2][2];
    const char* cA = (const char*)g.A + (size_t)cur.pm * tstep; const char* cB = (const char*)g.Bt + (size_t)cur.pn * tstep;
    S.a_ready(cur);
    if constexpr (SP2) {
        PG8_STAGE(PG8_SB(0, 0), cB, voffB); PG8_STAGE(PG8_SB(0, 1), cB + hstep, voffB); PG8_STAGE(PG8_SA(0, 0), cA, voffA); PG8_STAGE(PG8_SA(0, 1), cA + hstep, voffA);
        if (wr == 1) PG8_BAR;
        PG8_WAIT_V(2); PG8_BAR;
        PG8_STAGE(PG8_SB(1, 0), cB + kstep, voffB); PG8_STAGE(PG8_SA(1, 0), cA + kstep, voffA); PG8_STAGE(PG8_SB(1, 1), cB + hstep + kstep, voffB);
        PG8_WAIT_V(6); PG8_BAR;
    } else {
        PG8_STAGE(PG8_SB(0, 0), cB, voffB); PG8_STAGE(PG8_SA(0, 0), cA, voffA); PG8_STAGE(PG8_SB(0, 1), cB + hstep, voffB); PG8_STAGE(PG8_SA(0, 1), cA + hstep, voffA);
        if (wr == 1) PG8_BAR;
        PG8_WAIT_V(4); PG8_BAR;
        PG8_STAGE(PG8_SB(1, 0), cB + kstep, voffB); PG8_STAGE(PG8_SA(1, 0), cA + kstep, voffA); PG8_STAGE(PG8_SB(1, 1), cB + hstep + kstep, voffB);
        PG8_WAIT_V(6); PG8_BAR;
    }
    for (;;) {
        const bool has_next = S.next(ui + 1, nxt);
        const char* nA = has_next ? (const char*)g.A + (size_t)nxt.pm * tstep : cA; const char* nB = has_next ? (const char*)g.Bt + (size_t)nxt.pn * tstep : cB;
        for (int t = 0; t < nt; t += 2) {
            const bool last = (t == nt - 2);
            const char* a1 = cA + (size_t)(t + 1) * kstep;
            const char* a2 = last ? nA : cA + (size_t)(t + 2) * kstep; const char* b2 = last ? nB : cB + (size_t)(t + 2) * kstep;
            const char* a3 = a2 + kstep; const char* b3 = b2 + kstep;
            if (last && has_next) S.a_ready(nxt);
            if constexpr (SP2) {
            PG8_LDB(B0, 0, 0); PG8_LDB(B1, 0, 1); PG8_SCHED; PG8_LDA(At, 0, 0); PG8_STAGE(PG8_SA(1, 1), a1 + hstep, voffA);
            PG8_WAIT_V(8); PG8_WAIT_L(0); PG8_BAR; PG8_MMA(0, 0, At, B0); PG8_MMA(0, 1, At, B1); PG8_BAR; PG8_SCHED;
            PG8_LDA(At, 0, 1); PG8_STAGE(PG8_SB(0, 0), b2, voffB); PG8_STAGE(PG8_SB(0, 1), b2 + hstep, voffB); PG8_STAGE(PG8_SA(0, 0), a2, voffA);
            PG8_WAIT_V(8); PG8_WAIT_L(0); PG8_BAR; PG8_MMA(1, 0, At, B0); PG8_MMA(1, 1, At, B1); PG8_BAR; PG8_SCHED;
            PG8_LDB(B0, 1, 0); PG8_LDB(B1, 1, 1); PG8_SCHED; PG8_LDA(At, 1, 0); PG8_STAGE(PG8_SA(0, 1), a2 + hstep, voffA);
            PG8_WAIT_V(8); PG8_WAIT_L(0); PG8_BAR; PG8_MMA(0, 0, At, B0); PG8_MMA(0, 1, At, B1); PG8_BAR; PG8_SCHED;
            PG8_LDA(At, 1, 1); PG8_STAGE(PG8_SB(1, 0), b3, voffB); PG8_STAGE(PG8_SB(1, 1), b3 + hstep, voffB); PG8_STAGE(PG8_SA(1, 0), a3, voffA);
            PG8_WAIT_V(8); PG8_WAIT_L(0); PG8_BAR; PG8_MMA(1, 0, At, B0); PG8_MMA(1, 1, At, B1); PG8_BAR; PG8_SCHED;
            } else {
            PG8_LDB(B0, 0, 0); PG8_SCHED; PG8_LDA(At, 0, 0); PG8_STAGE(PG8_SA(1, 1), a1 + hstep, voffA);
            PG8_WAIT_L(8); PG8_BAR; PG8_WAIT_L(0); PG8_MMA(0, 0, At, B0); PG8_BAR; PG8_SCHED;
            PG8_LDB(B1, 0, 1); PG8_STAGE(PG8_SB(0, 0), b2, voffB);
            PG8_BAR; PG8_WAIT_L(0); PG8_MMA(0, 1, At, B1); PG8_BAR;
            PG8_LDA(At, 0, 1); PG8_STAGE(PG8_SA(0, 0), a2, voffA);
            PG8_BAR; PG8_WAIT_L(0); PG8_MMA(1, 0, At, B0); PG8_BAR; PG8_SCHED;
            PG8_STAGE(PG8_SB(0, 1), b2 + hstep, voffB);
            PG8_WAIT_V(6); PG8_BAR; PG8_MMA(1, 1, At, B1); PG8_BAR;
            PG8_LDB(B0, 1, 0); PG8_SCHED; PG8_LDA(At, 1, 0); PG8_STAGE(PG8_SA(0, 1), a2 + hstep, voffA);
            PG8_WAIT_L(8); PG8_BAR; PG8_WAIT_L(0); PG8_MMA(0, 0, At, B0); PG8_BAR; PG8_SCHED;
            PG8_LDB(B1, 1, 1); PG8_STAGE(PG8_SB(1, 0), b3, voffB);
            PG8_BAR; PG8_WAIT_L(0); PG8_MMA(0, 1, At, B1); PG8_BAR;
            PG8_LDA(At, 1, 1); PG8_STAGE(PG8_SA(1, 0), a3, voffA);
            PG8_BAR; PG8_WAIT_L(0); PG8_MMA(1, 0, At, B0); PG8_BAR; PG8_SCHED;
            PG8_STAGE(PG8_SB(1, 1), b3 + hstep, voffB);
            PG8_WAIT_V(6); PG8_BAR; PG8_MMA(1, 1, At, B1); PG8_BAR;
            }
        }
        if constexpr (ALIGN_EPI) { if (wr == 0) PG8_BAR; }
        if constexpr (!Epi::AFTER_DRAIN) { E(acc, cur, wr, wc, fr, fq); S.done(cur); }
        if (!has_next) break;
#pragma unroll
        for (int a = 0; a < 2; ++a)
#pragma unroll
            for (int b = 0; b < 2; ++b)
#pragma unroll
                for (int m = 0; m < 4; ++m)
#pragma unroll
                    for (int n = 0; n < 2; ++n) acc[a][b][m][n] = (f32x4){0.f, 0.f, 0.f, 0.f};
        cur = nxt; cA = nA; cB = nB; ++ui;
        if constexpr (ALIGN_EPI) { if (wr == 1) PG8_BAR; }
    }
    PG8_WAIT_V(0);
    if constexpr (!ALIGN_EPI) { if (wr == 0) PG8_BAR; }
    PG8_BAR;
    if constexpr (Epi::AFTER_DRAIN) { E.fused(acc, cur, wr, wc, fr, fq, lds, wid, lane); S.done(cur); }
#undef PG8_SA
#undef PG8_SB
#undef PG8_STAGE
#undef PG8_LDA
#undef PG8_LDB
#undef PG8_MMA
#undef PG8_WAIT_V
#undef PG8_WAIT_L
#undef PG8_BAR
#undef PG8_SCHED
}
}
#include <hip/hip_bf16.h>
#include <cmath>
namespace attn_body {
using bf16=__hip_bfloat16;
using bf16x8=__attribute__((ext_vector_type(8)))short;
using s16x4=__attribute__((ext_vector_type(4)))short;
using f32x16=__attribute__((ext_vector_type(16)))float;
using u32x4=__attribute__((ext_vector_type(4)))unsigned;
constexpr int SEQ=2048,SKV=2304,D=64,QP=512,KP=128,OP=1024;
constexpr int NW=8,QBLK=32,QB=QBLK*NW,KVBLK=64,NQB=SEQ/QB;
constexpr int ATTN_UNIT_ROWS=QB;
__device__ __forceinline__ int crow(int r,int hi){return (r&3)+8*(r>>2)+4*hi;}
#define SBAR() __builtin_amdgcn_sched_barrier(0)
__device__ __forceinline__ void cmask(f32x16&p0,f32x16&p1,int jb,int qrel,int hi){
  const float NEG=-INFINITY; int kb=64*jb+4*hi;
  #pragma unroll
  for(int r=0;r<16;++r){int kv=kb+(r&3)+8*(r>>2); if(kv>qrel)p0[r]=NEG; if(kv+32>qrel)p1[r]=NEG;}
}

constexpr int NSLOT=3, SLOTB=8192;
constexpr int LDS_K=0, LDS_V=NSLOT*SLOTB, LDS_WS=2*NSLOT*SLOTB, LDS_OST=LDS_WS+NW*64*4, LDS_BYTES=LDS_OST+NW*4096;
constexpr float C2=0.125f*1.4426950408889634f;
__device__ __forceinline__ void glds16(const void*gsrc,unsigned lds_dst){unsigned keep;
  asm volatile("s_mov_b32 %0, m0\n\ts_mov_b32 m0, %2\n\ts_nop 0\n\tglobal_load_lds_dwordx4 %1, off\n\ts_mov_b32 m0, %0":"=&s"(keep):"v"(gsrc),"s"(lds_dst):"memory");}
__device__ __forceinline__ float max3f(float a,float b,float c){float r;asm("v_max3_f32 %0, %1, %2, %3":"=v"(r):"v"(a),"v"(b),"v"(c));return r;}
__device__ __forceinline__ float max2f(float a,float b){float r;asm("v_max_f32_e32 %0, %1, %2":"=v"(r):"v"(a),"v"(b));return r;}
__device__ __forceinline__ float fadd_s(float a,float b){float r;asm("v_add_f32_e32 %0, %1, %2":"=v"(r):"v"(a),"v"(b));return r;}
__device__ __forceinline__ float fsub_s(float a,float b){float r;asm("v_sub_f32_e32 %0, %1, %2":"=v"(r):"v"(a),"v"(b));return r;}
typedef float f32x2_t __attribute__((ext_vector_type(2))); typedef __bf16 bf16x2_t __attribute__((ext_vector_type(2)));
__device__ __forceinline__ unsigned cvtpk_s(float lo,float hi){f32x2_t v={lo,hi};bf16x2_t b=__builtin_convertvector(v,bf16x2_t);return __builtin_bit_cast(unsigned,b);}
#define WAIT_BAR(N) asm volatile("s_waitcnt vmcnt(" #N ") lgkmcnt(0)\n\ts_barrier":::"memory")

__device__ __forceinline__ void qkt(f32x16&p0,f32x16&p1,const char*Kslot,const bf16x8*qr,const f32x16&negm,int r32,int hi){
  const char*kb=Kslot+hi*1024+r32*16;
  #pragma unroll
  for(int d0=0;d0<4;++d0){
    const bf16x8 b0=*reinterpret_cast<const bf16x8*>(kb+d0*2048);
    const bf16x8 b1=*reinterpret_cast<const bf16x8*>(kb+d0*2048+512);
    if(d0==0){p0=__builtin_amdgcn_mfma_f32_32x32x16_bf16(b0,qr[0],negm,0,0,0);p1=__builtin_amdgcn_mfma_f32_32x32x16_bf16(b1,qr[0],negm,0,0,0);}
    else{p0=__builtin_amdgcn_mfma_f32_32x32x16_bf16(b0,qr[d0],p0,0,0,0);p1=__builtin_amdgcn_mfma_f32_32x32x16_bf16(b1,qr[d0],p1,0,0,0);}}
}
typedef __attribute__((address_space(3))) const char* lds_cptr;
typedef short v4i16_t __attribute__((ext_vector_type(4)));
__device__ __forceinline__ void kload8(bf16x8*kf,lds_cptr kp){
  kf[0]=*(const __attribute__((address_space(3))) bf16x8*)(kp);      kf[1]=*(const __attribute__((address_space(3))) bf16x8*)(kp+512);
  kf[2]=*(const __attribute__((address_space(3))) bf16x8*)(kp+2048); kf[3]=*(const __attribute__((address_space(3))) bf16x8*)(kp+2560);
  kf[4]=*(const __attribute__((address_space(3))) bf16x8*)(kp+4096); kf[5]=*(const __attribute__((address_space(3))) bf16x8*)(kp+4608);
  kf[6]=*(const __attribute__((address_space(3))) bf16x8*)(kp+6144); kf[7]=*(const __attribute__((address_space(3))) bf16x8*)(kp+6656);
}
__device__ __forceinline__ void kload2(bf16x8*kf,lds_cptr kp,int j){ kf[2*j]=*(const __attribute__((address_space(3))) bf16x8*)(kp+j*2048); kf[2*j+1]=*(const __attribute__((address_space(3))) bf16x8*)(kp+j*2048+512); }
__device__ __forceinline__ s16x4 vtr(lds_cptr p){ return __builtin_bit_cast(s16x4,__builtin_amdgcn_ds_read_tr16_b64_v4i16((__attribute__((address_space(3))) v4i16_t*)p)); }
__device__ __forceinline__ float rowmax(const f32x16&p0,const f32x16&p1){
  float a=max3f(p0[0],p0[1],p1[0]),b=max3f(p0[2],p0[3],p1[1]);a=max3f(a,p1[2],p1[3]);
  #pragma unroll
  for(int r=4;r<16;r+=4){a=max3f(a,p0[r],p0[r+1]);b=max3f(b,p0[r+2],p0[r+3]);a=max3f(a,p1[r],p1[r+1]);b=max3f(b,p1[r+2],p1[r+3]);}
  const float m=max2f(a,b);
  auto rr=__builtin_amdgcn_permlane32_swap(__float_as_uint(m),__float_as_uint(m),false,false);
  return max2f(__uint_as_float(rr[0]),__uint_as_float(rr[1]));
}
__device__ __forceinline__ void pv(f32x16*o,int vb,bf16x8 pa0,bf16x8 pa1,bf16x8 pa2,bf16x8 pa3){
  #pragma unroll
  for(int d0=0;d0<2;++d0){s16x4 lo[4],hi[4];
    #pragma unroll
    for(int ks=0;ks<4;++ks){
      asm volatile("ds_read_b64_tr_b16 %0,%1 offset:%c2":"=&v"(lo[ks]):"v"(vb),"i"(d0*4096+ks*1024):"memory");
      asm volatile("ds_read_b64_tr_b16 %0,%1 offset:%c2":"=&v"(hi[ks]):"v"(vb),"i"(d0*4096+ks*1024+512):"memory");}
    asm volatile("s_waitcnt lgkmcnt(0)":::"memory");SBAR();
    #define PK(k) (bf16x8){lo[k][0],lo[k][1],lo[k][2],lo[k][3],hi[k][0],hi[k][1],hi[k][2],hi[k][3]}
    o[d0]=__builtin_amdgcn_mfma_f32_32x32x16_bf16(pa0,PK(0),o[d0],0,0,0);
    o[d0]=__builtin_amdgcn_mfma_f32_32x32x16_bf16(pa1,PK(1),o[d0],0,0,0);
    o[d0]=__builtin_amdgcn_mfma_f32_32x32x16_bf16(pa2,PK(2),o[d0],0,0,0);
    o[d0]=__builtin_amdgcn_mfma_f32_32x32x16_bf16(pa3,PK(3),o[d0],0,0,0);
    #undef PK
  }
}

#ifndef ATTN_STORE16
#define ATTN_STORE16(p,v) (*(u32x4*)(p)=(v))
#endif
template<int THRL,bool FIX> __device__ __forceinline__ void attn_unit(float mfix,int b,int h,int qb,const bf16*Q,const bf16*__restrict__ K,const bf16*__restrict__ V,const bf16*__restrict__ Z,bf16*O,char*shm){
  const int tid=threadIdx.x,lane=tid&63,r32=lane&31,hi=lane>>5; const int wid=__builtin_amdgcn_readfirstlane(tid>>6);
  const long rowbase=(long)b*SEQ; const int q0=qb*QB;
  const bf16*Qw=Q+(rowbase+q0+wid*QBLK)*QP+h*D;
  const long kvbase=(long)b*SKV*KP+(h>>2)*D; const bf16*Kh=K+kvbase,*Vh=V+kvbase;
  const unsigned lds0=(unsigned)(uintptr_t)shm;
  float*wsf=(float*)(shm+LDS_WS)+wid*64;
  const bf16*ksrc=Kh+(long)lane*KP+wid*8;
  const bf16*vsrc=Vh+(long)(16*(wid&3)+(lane>>2))*KP+(wid>>2)*32+(lane&3)*8;
  const unsigned kdst=lds0+LDS_K+wid*1024, vdst=lds0+LDS_V+wid*1024;
  #define DMA_K(t,slot) glds16(ksrc+(long)(t)*KVBLK*KP,(unsigned)__builtin_amdgcn_readfirstlane(kdst+(slot)))
  #define DMA_V(t,slot) glds16(vsrc+(long)(t)*KVBLK*KP,(unsigned)__builtin_amdgcn_readfirstlane(vdst+(slot)))
  const int vb0=(int)(lds0+LDS_V)+((lane>>4)&1)*32+(lane&3)*8+(4*hi+((lane&15)>>2))*64;
  const char*Kbase=shm+LDS_K; bf16x8 kf[8];
  const lds_cptr shm3=(lds_cptr)shm; const lds_cptr kp0=shm3+LDS_K+hi*1024+r32*16; const lds_cptr vp0=shm3+LDS_V+((lane>>4)&1)*32+(lane&3)*8+(4*hi+((lane&15)>>2))*64;
  constexpr int NT=SKV/KVBLK;
  DMA_K(0,0);DMA_V(0,0);DMA_K(1,SLOTB);
  bf16x8 qr[4];
  #pragma unroll
  for(int d0=0;d0<4;++d0)qr[d0]=*reinterpret_cast<const bf16x8*>(&Qw[(long)r32*QP+d0*16+hi*8]);
  float mhat=0.f,l_reg=0.f;f32x16 o[2];o[0]=f32x16{};o[1]=f32x16{};f32x16 negm=f32x16{};
  if constexpr(FIX){ mhat=mfix; _Pragma("unroll") for(int r=0;r<16;++r)negm[r]=-mfix; }
  asm volatile("":"+v"(negm));
  const int qrel=wid*QBLK+r32;
  #define CMASK(P0,P1,t) do{}while(0)
  bool resc=false;
  #define START(P0,P1) do{ resc=false; \
    if constexpr(!FIX){ const float rm=rowmax(P0,P1); const float dl=rm; mhat=fadd_s(mhat,dl); \
      _Pragma("unroll") for(int r=0;r<16;++r){P0[r]=fsub_s(P0[r],dl);P1[r]=fsub_s(P1[r],dl);} \
      _Pragma("unroll") for(int r=0;r<16;++r)negm[r]=-mhat; asm volatile("":"+v"(negm)); } \
    _Pragma("unroll") for(int r=0;r<16;++r)P0[r]=__builtin_amdgcn_exp2f(P0[r]); }while(0)
  #define RESC() do{ if(resc){ asm volatile("s_waitcnt lgkmcnt(0)":::"memory"); \
      _Pragma("unroll") for(int d_=0;d_<2;++d_) _Pragma("unroll") for(int r=0;r<16;++r)o[d_][r]*=wsf[crow(r,hi)]; } }while(0)
  f32x16 pA0,pA1,pB0,pB1;
  int sl_prev=0,sl_cur=0,sl_next=SLOTB;
  #define ROT() do{sl_prev=sl_cur;sl_cur=sl_next;sl_next=(sl_next==(NSLOT-1)*SLOTB)?0:sl_next+SLOTB;}while(0)
  DMA_K(2,2*SLOTB);
  WAIT_BAR(3);
  qkt(pA0,pA1,Kbase,qr,negm,r32,hi);asm volatile("s_nop 15\n\ts_nop 7":"+v"(pA0),"+v"(pA1));CMASK(pA0,pA1,0);
  START(pA0,pA1);
  _Pragma("unroll") for(int r=0;r<16;++r)pA1[r]=__builtin_amdgcn_exp2f(pA1[r]);
  WAIT_BAR(0);
  DMA_K(3,0);DMA_V(1,SLOTB);
  ROT();
  kload8(kf,kp0+sl_cur);
  WAIT_BAR(2);
  s16x4 vlo[8],vhi[8]; u32x4 pw0,pw1,pw2,pw3;
  #define PKW(P,B) cvtpk_s(P[B],P[B+1])
  #define PAF(k) __builtin_bit_cast(bf16x8,pw##k)
  #define VFR(i) (bf16x8){vlo[i][0],vlo[i][1],vlo[i][2],vlo[i][3],vhi[i][0],vhi[i][1],vhi[i][2],vhi[i][3]}
  #define PIN(x) asm volatile("":"+v"(x))
  #define MX3(a,b,c) __builtin_fmaxf(__builtin_fmaxf((a),(b)),(c))
  #define GAPA(MF,A0,A1,A2,A3,W0,W1,PW) do{ MF; sacc+=A0; sacc+=A1; sacc+=A2; sacc+=A3; PIN(sacc); W0; W1; PIN(PW); SBAR(); }while(0)
  #define EX(v) __builtin_amdgcn_exp2f(v)
  #define GAPB(MF,X,B) do{ MF; X[B]=EX(X[B]); X[B+1]=EX(X[B+1]); X[B+2]=EX(X[B+2]); X[B+3]=EX(X[B+3]); PIN(X); SBAR(); }while(0)
  #define VRD(i) do{ vlo[i]=vtr(vp_+(((i)>>2)*4096+((i)&3)*1024)); vhi[i]=vtr(vp_+(((i)>>2)*4096+((i)&3)*1024+512)); }while(0)
  #define KRD(G,j) do{ if(G){ kload2(kf,kp0+sl_next,j); SBAR(); } }while(0)
  #define STEP(C0,C1,P0,P1,t,GK,GV,GL) do{ SBAR(); \
    const lds_cptr vp_=vp0+sl_prev; \
    VRD(0); SBAR(); float sacc=(P0[0]+P0[1]); \
    GAPA(C0=__builtin_amdgcn_mfma_f32_32x32x16_bf16(kf[0],qr[0],negm,0,0,0), P0[2],P0[3],P0[4],P0[5],     pw0[0]=PKW(P0,0), pw0[1]=PKW(P0,2), pw0); \
    VRD(4); SBAR(); GAPA(C1=__builtin_amdgcn_mfma_f32_32x32x16_bf16(kf[1],qr[0],negm,0,0,0), P0[6],P0[7],P0[8],P0[9],     pw0[2]=PKW(P0,4), pw0[3]=PKW(P0,6), pw0); \
    VRD(1); SBAR(); GAPA(C0=__builtin_amdgcn_mfma_f32_32x32x16_bf16(kf[2],qr[1],C0,0,0,0),   P0[10],P0[11],P0[12],P0[13], pw1[0]=PKW(P0,8), pw1[1]=PKW(P0,10), pw1); \
    VRD(5); SBAR(); GAPA(C1=__builtin_amdgcn_mfma_f32_32x32x16_bf16(kf[3],qr[1],C1,0,0,0),   P0[14],P0[15],P1[0],P1[1],   pw1[2]=PKW(P0,12),pw1[3]=PKW(P0,14), pw1); \
    VRD(2); SBAR(); GAPA(C0=__builtin_amdgcn_mfma_f32_32x32x16_bf16(kf[4],qr[2],C0,0,0,0),   P1[2],P1[3],P1[4],P1[5],     pw2[0]=PKW(P1,0), pw2[1]=PKW(P1,2), pw2); \
    VRD(6); SBAR(); GAPA(C1=__builtin_amdgcn_mfma_f32_32x32x16_bf16(kf[5],qr[2],C1,0,0,0),   P1[6],P1[7],P1[8],P1[9],     pw2[2]=PKW(P1,4), pw2[3]=PKW(P1,6), pw2); \
    VRD(3); SBAR(); GAPA(C0=__builtin_amdgcn_mfma_f32_32x32x16_bf16(kf[6],qr[3],C0,0,0,0),   P1[10],P1[11],P1[12],P1[13], pw3[0]=PKW(P1,8), pw3[1]=PKW(P1,10), pw3); \
    VRD(7); SBAR(); GAPA(C1=__builtin_amdgcn_mfma_f32_32x32x16_bf16(kf[7],qr[3],C1,0,0,0),   P1[14],P1[15],0.f,0.f,       pw3[2]=PKW(P1,12),pw3[3]=PKW(P1,14), pw3); \
    l_reg+=sacc; \
    if(GK){DMA_K((t)+3,sl_cur);} if(GV){DMA_V((t)+1,sl_next);} \
    CMASK(C0,C1,t); \
    if constexpr(!FIX){ float a=MX3(C0[0],C0[1],C1[0]),b=MX3(C0[2],C0[3],C1[1]); a=MX3(a,C1[2],C1[3]); \
      _Pragma("unroll") for(int r=4;r<16;r+=4){a=MX3(a,C0[r],C0[r+1]);b=MX3(b,C0[r+2],C0[r+3]);a=MX3(a,C1[r],C1[r+1]);b=MX3(b,C1[r+2],C1[r+3]);} \
      float rm=__builtin_fmaxf(a,b); { auto rr=__builtin_amdgcn_permlane32_swap(__float_as_uint(rm),__float_as_uint(rm),false,false); rm=__builtin_fmaxf(__uint_as_float(rr[0]),__uint_as_float(rr[1])); } \
      resc=false; \
      if(__builtin_expect(__any(rm>(float)THRL),0)){ const float dl=__builtin_fmaxf(rm,0.f); mhat+=dl; \
        _Pragma("unroll") for(int r=0;r<16;++r){C0[r]-=dl;C1[r]-=dl;} \
        _Pragma("unroll") for(int r=0;r<16;++r)negm[r]=-mhat; asm volatile("":"+v"(negm)); \
        const float f=__builtin_amdgcn_exp2f(-dl); l_reg*=f; if(hi==0)wsf[r32]=f; resc=true; } } \
    SBAR(); \
    GAPB(o[0]=__builtin_amdgcn_mfma_f32_32x32x16_bf16(PAF(0),VFR(0),o[0],0,0,0), C0,0); \
    GAPB(o[1]=__builtin_amdgcn_mfma_f32_32x32x16_bf16(PAF(0),VFR(4),o[1],0,0,0), C0,4); \
    KRD(GL,0); GAPB(o[0]=__builtin_amdgcn_mfma_f32_32x32x16_bf16(PAF(1),VFR(1),o[0],0,0,0), C0,8); \
    KRD(GL,1); GAPB(o[1]=__builtin_amdgcn_mfma_f32_32x32x16_bf16(PAF(1),VFR(5),o[1],0,0,0), C0,12); \
    KRD(GL,2); GAPB(o[0]=__builtin_amdgcn_mfma_f32_32x32x16_bf16(PAF(2),VFR(2),o[0],0,0,0), C1,0); \
    KRD(GL,3); GAPB(o[1]=__builtin_amdgcn_mfma_f32_32x32x16_bf16(PAF(2),VFR(6),o[1],0,0,0), C1,4); \
    GAPB(o[0]=__builtin_amdgcn_mfma_f32_32x32x16_bf16(PAF(3),VFR(3),o[0],0,0,0), C1,8); \
    GAPB(o[1]=__builtin_amdgcn_mfma_f32_32x32x16_bf16(PAF(3),VFR(7),o[1],0,0,0), C1,12); \
    }while(0)
  int t=1;
  #undef CMASK
  #define CMASK(P0,P1,t) do{}while(0)
  for(;t+5<NT;t+=2){
    STEP(pB0,pB1,pA0,pA1,t,true,true,true);     WAIT_BAR(2); RESC(); ROT();
    STEP(pA0,pA1,pB0,pB1,t+1,true,true,true);   WAIT_BAR(2); RESC(); ROT();
  }
  #undef CMASK
  #define CMASK(P0,P1,t) do{}while(0)
  #define ENDW(tt) do{ if((tt)+3<NT){WAIT_BAR(2);} else if((tt)+2<NT){WAIT_BAR(1);} else {WAIT_BAR(0);} }while(0)
  for(;t+1<NT;t+=2){
    STEP(pB0,pB1,pA0,pA1,t,(t+3<NT),(t+1<NT),(t+1<NT));       ENDW(t);   RESC(); ROT();
    STEP(pA0,pA1,pB0,pB1,t+1,(t+4<NT),(t+2<NT),(t+2<NT));     ENDW(t+1); RESC(); ROT();
  }
  STEP(pB0,pB1,pA0,pA1,NT-1,false,false,false); RESC();
  { float sacc=pB0[0]+pB0[1]; _Pragma("unroll") for(int r=2;r<16;++r)sacc+=pB0[r]; _Pragma("unroll") for(int r=0;r<16;++r)sacc+=pB1[r]; l_reg+=sacc;
    pw0=(u32x4){PKW(pB0,0),PKW(pB0,2),PKW(pB0,4),PKW(pB0,6)};pw1=(u32x4){PKW(pB0,8),PKW(pB0,10),PKW(pB0,12),PKW(pB0,14)};pw2=(u32x4){PKW(pB1,0),PKW(pB1,2),PKW(pB1,4),PKW(pB1,6)};pw3=(u32x4){PKW(pB1,8),PKW(pB1,10),PKW(pB1,12),PKW(pB1,14)};
    SBAR(); pv(o,vb0+sl_cur,PAF(0),PAF(1),PAF(2),PAF(3)); }
  #undef PKW
  #undef PAF
  #undef VFR
  #undef PIN
  #undef MX3
  #undef GAPA
  #undef GAPB
  #undef EX
  #undef VRD
  #undef KRD
  #undef STEP
  #undef ENDW
  {auto rr=__builtin_amdgcn_permlane32_swap(__float_as_uint(l_reg),__float_as_uint(l_reg),false,false);l_reg=__uint_as_float(rr[0])+__uint_as_float(rr[1]);}
  if(hi==0)wsf[32+r32]=l_reg;asm volatile("s_waitcnt lgkmcnt(0)":::"memory");
  float rli[16];
  #pragma unroll
  for(int r=0;r<16;++r)rli[r]=__builtin_amdgcn_rcpf(wsf[32+crow(r,hi)]);
  const long orow0=(rowbase+q0+wid*QBLK)*OP+h*D; bf16*Ow=O+orow0; const bf16*Zw=Z+orow0;
  { bf16*stg=(bf16*)(shm+LDS_OST)+wid*2048;
    #pragma unroll
    for(int r=0;r<16;++r){const int orow=crow(r,hi);
      #pragma unroll
      for(int d0=0;d0<2;++d0)stg[orow*64+d0*32+r32]=__float2bfloat16(o[d0][r]*rli[r]);}
    asm volatile("s_waitcnt lgkmcnt(0)":::"memory");
    #pragma unroll
    for(int i=0;i<4;++i){const int row=i*8+(lane>>3),ch=lane&7; const u32x4 v=*(const u32x4*)(stg+row*64+ch*8); const u32x4 z=*(const u32x4*)(Zw+(long)row*OP+ch*8);
      u32x4 w; w.x=cvtpk_s(__uint_as_float(v.x<<16)*__uint_as_float(z.x<<16),__uint_as_float(v.x&0xffff0000u)*__uint_as_float(z.x&0xffff0000u));
      w.y=cvtpk_s(__uint_as_float(v.y<<16)*__uint_as_float(z.y<<16),__uint_as_float(v.y&0xffff0000u)*__uint_as_float(z.y&0xffff0000u));
      w.z=cvtpk_s(__uint_as_float(v.z<<16)*__uint_as_float(z.z<<16),__uint_as_float(v.z&0xffff0000u)*__uint_as_float(z.z&0xffff0000u));
      w.w=cvtpk_s(__uint_as_float(v.w<<16)*__uint_as_float(z.w<<16),__uint_as_float(v.w&0xffff0000u)*__uint_as_float(z.w&0xffff0000u));
      ATTN_STORE16(Ow+(long)row*OP+ch*8,w);} }
  asm volatile("s_waitcnt lgkmcnt(0)\n\ts_barrier":::"memory");
  #undef DMA_K
  #undef DMA_V
  #undef CMASK
  #undef START
  #undef RESC
  #undef ROT
}
constexpr int ATTN_LDS_BYTES=LDS_BYTES;
struct AttnTensors { const bf16* Q; const bf16* K; const bf16* V; const bf16* Z; bf16* O; };
template<int THRL,bool FIX> __device__ __forceinline__ void attn_phase(char*lds,const AttnTensors&T,int vcu,int G,float mfix){
  for(int u=vcu;u<1024;u+=G){ const int un=(G==256)?((vcu<<2)+((u-vcu)>>8)):u;
    attn_unit<THRL,FIX>(mfix,un>>6,(un>>3)&7,un&7,T.Q,T.K,T.V,T.Z,T.O,lds); }
}
#undef SBAR
#undef WAIT_BAR
}
constexpr int NWAVES = 8;
constexpr int BATCH = 16, SEQ = 2048, DM = 1024, CTX = 256, DIN = 2816, DCONV = 512;
constexpr int M = BATCH * SEQ;
constexpr int MC = BATCH * CTX;
constexpr size_t MiB = 1u << 20;
constexpr size_t WS_MOD = 0, WS_ROPE = 1 * MiB, WS_WIN = 2 * MiB, WS_WPW = 8 * MiB, WS_WOUT = 9 * MiB, WS_U = 16 * MiB, WS_Q = 88 * MiB, WS_KA = 120 * MiB, WS_VA = 130 * MiB,
                 WS_CTL = 12 * MiB, WS_Z = 140 * MiB, WS_UG = 204 * MiB, WS_Y = 236 * MiB, WS_MIX = 268 * MiB, WS_END = 332 * MiB;
constexpr size_t CTL_ZERO_BYTES = 16384;
constexpr int RING_BYTES = 131072, MISC_OFF = RING_BYTES + 320, LDS_BYTES = 147456;
#define LAS __attribute__((address_space(3)))
typedef unsigned short bf16;
typedef unsigned v4u __attribute__((ext_vector_type(4)));
typedef float f32x4 __attribute__((ext_vector_type(4)));
typedef float f32x2 __attribute__((ext_vector_type(2)));
#define LDS_WAIT() asm volatile("s_waitcnt lgkmcnt(0)" ::: "memory")
__device__ __forceinline__ unsigned pk2(float lo, float hi) { return pg8::cvt_pk_bf16(lo, hi); }
__device__ __forceinline__ float wave_sum(float v) {
#pragma unroll
    for (int o = 1; o < 64; o <<= 1) v += __shfl_xor(v, o);
    return v;
}
#define GAS __attribute__((address_space(1)))
#define RLX_AGENT __ATOMIC_RELAXED, __HIP_MEMORY_SCOPE_AGENT
#define XB_TMO      128
#define XB_XCNT(j)  (256  + 64 * (j))
#define XB_XSUB(j)  (1280 + 64 * (j))
#define XB_XGEN(j)  (2304 + 64 * (j))
#define XB_TOP      3328
#define XB_TOPGEN   3392
#define XCD_BAR_WORDS 3456
#define XB_SPIN_CAP (1u << 18)

__device__ __forceinline__ unsigned xb_ld(unsigned* p)              { return __hip_atomic_load(p, __ATOMIC_RELAXED, __HIP_MEMORY_SCOPE_AGENT); }
__device__ __forceinline__ unsigned xb_add(unsigned* p, unsigned v) { return __hip_atomic_fetch_add(p, v, __ATOMIC_RELAXED, __HIP_MEMORY_SCOPE_AGENT); }
__device__ __forceinline__ unsigned xb_xcc_id() { return (unsigned)__builtin_amdgcn_s_getreg((3 << 11) | 20) & 0xFu; }
#define XB_SPIN(cond, bar) do { unsigned _sp = 0; while (cond) { __builtin_amdgcn_s_sleep(1); \
    if ((++_sp & 255u) == 0u) { if (xb_ld(&(bar)[XB_TMO])) break; if (_sp > XB_SPIN_CAP) { atomicAdd(&(bar)[XB_TMO], 1u); break; } } } } while (0)

struct XcdBarrier {
    unsigned* bar; unsigned x;
    volatile LAS unsigned* st;
};

__device__ __forceinline__ XcdBarrier xcd_barrier_post(unsigned* bar, volatile LAS unsigned* st) {
    XcdBarrier b; b.bar = bar; b.x = xb_xcc_id(); b.st = st;
    if (threadIdx.x == 0) (void)xb_add(&bar[XB_XCNT(b.x)], 1u);
    return b;
}
__device__ __forceinline__ void xcd_barrier_complete(unsigned* bar, unsigned x, unsigned& nloc, unsigned& nx) {
    const unsigned G = gridDim.x * gridDim.y * gridDim.z;
    unsigned sum, cnt, mine, sp = 0u;
    for (;;) {
        sum = 0u; cnt = 0u; mine = 0u;
#pragma unroll
        for (unsigned j = 0; j < 16; ++j) { const unsigned c = xb_ld(&bar[XB_XCNT(j)]); sum += c; cnt += (c > 0u) ? 1u : 0u; mine = (j == x) ? c : mine; }
        if (sum == G) break;
        __builtin_amdgcn_s_sleep(1);
        if ((++sp & 255u) == 0u) { if (xb_ld(&bar[XB_TMO])) break; if (sp > XB_SPIN_CAP) { atomicAdd(&bar[XB_TMO], 1u); break; } }
    }
    nloc = mine > 0u ? mine : 1u; nx = cnt > 0u ? cnt : 1u;
}

__device__ __forceinline__ void xcd_barrier(const XcdBarrier& b) {
    asm volatile("s_waitcnt vmcnt(0)" ::: "memory");
    __syncthreads();
    if (threadIdx.x == 0) {
        unsigned* bar = b.bar;
        __builtin_amdgcn_s_waitcnt(0);
        unsigned nloc = b.st[0], nx = b.st[1];
        if (nloc == 0u) { xcd_barrier_complete(bar, b.x, nloc, nx); b.st[0] = nloc; b.st[1] = nx; }
        const unsigned old = xb_add(&bar[XB_XSUB(b.x)], 1u);
        const unsigned gen = old / nloc;
        if (old + 1u == (gen + 1u) * nloc) {
            __builtin_amdgcn_fence(__ATOMIC_RELEASE, "agent");
            asm volatile("s_waitcnt vmcnt(0)" ::: "memory");
            const unsigned og = xb_add(&bar[XB_TOP], 1u);
            const unsigned tg = og / nx;
            if (og + 1u == (tg + 1u) * nx) xb_add(&bar[XB_TOPGEN], 1u);
            else XB_SPIN(xb_ld(&bar[XB_TOPGEN]) == tg, bar);
            __builtin_amdgcn_fence(__ATOMIC_ACQUIRE, "agent");
            xb_add(&bar[XB_XGEN(b.x)], 1u);
            asm volatile("s_waitcnt vmcnt(0)" ::: "memory");
        } else {
            XB_SPIN(xb_ld(&bar[XB_XGEN(b.x)]) == gen, bar);
            __builtin_amdgcn_fence(__ATOMIC_ACQUIRE, "agent");
            asm volatile("s_waitcnt vmcnt(0)" ::: "memory");
        }
    }
    __syncthreads();
}
__device__ __forceinline__ int lmap_in(int P) {
    if (P < 768) { const int tile = P >> 8, p = P & 255, bj = p >> 7, wc = (p >> 5) & 3, j = p & 31; return tile * 256 + wc * 64 + ((j < 16) ? j : j + 16) + 16 * bj; }
    if (P >= 1280 && P < 2304) { const int q = P - 1280, T = q >> 8, p = q & 255; return (p < 128) ? (1280 + 128 * T + p) : (1792 + 128 * T + (p - 128)); }
    return P;
}
template <bool MAP> __device__ __forceinline__ void p0_transpose_item(const float* W, int K, int N, bf16* WT, LAS float* scr, int item, int lane) {
    const int nblk = N / 32, kb = item / nblk, nb = item % nblk, k0 = 64 * kb, n0 = 32 * nb;
    const int ncol = MAP ? lmap_in(n0 + (lane & 31)) : (n0 + (lane & 31));
#pragma unroll 8
    for (int i = 0; i < 32; ++i) { const int kk = 2 * i + (lane >> 5); scr[kk * 33 + (lane & 31)] = __builtin_nontemporal_load(W + (size_t)(k0 + kk) * N + ncol); }
    LDS_WAIT(); asm volatile("" ::: "memory");
    const int c = lane & 7;
#pragma unroll
    for (int j = 0; j < 4; ++j) { const int n = (lane >> 3) + 8 * j; const LAS float* s = scr + (8 * c) * 33 + n;
        v4u o; o.x = pk2(s[0 * 33], s[1 * 33]); o.y = pk2(s[2 * 33], s[3 * 33]); o.z = pk2(s[4 * 33], s[5 * 33]); o.w = pk2(s[6 * 33], s[7 * 33]);
        *(v4u*)(WT + (size_t)(n0 + n) * K + k0 + 8 * c) = o; }
    LDS_WAIT(); asm volatile("" ::: "memory");
}
__device__ __forceinline__ void mod_item(LAS unsigned char* lds, const float* c, const float* cctx, const float* wmod, const float* bmod, float* MOD, int nc, int tid) {
    LAS float* sc = (LAS float*)lds;
    LAS float* part = sc + 17 * 1024;
    const int w = tid >> 6, lane = tid & 63, col = lane & 15, kq = lane >> 4, n = nc * 16 + col, kbase = 128 * w + 32 * kq;
    float wv[32];
#pragma unroll
    for (int i = 0; i < 32; ++i) wv[i] = __builtin_nontemporal_load(wmod + (size_t)(kbase + i) * 3072 + n);
    for (int idx = tid; idx < 17 * 1024; idx += 512) { const int r = idx >> 10, k = idx & 1023; const float v = (r < 16) ? c[r * 1024 + k] : cctx[k]; sc[idx] = pg8::silu_f(v); }
    __syncthreads();
    float acc[17];
#pragma unroll
    for (int r = 0; r < 17; ++r) acc[r] = 0.f;
#pragma unroll
    for (int i = 0; i < 32; ++i) {
#pragma unroll
        for (int r = 0; r < 17; ++r) acc[r] += sc[r * 1024 + kbase + i] * wv[i]; }
#pragma unroll
    for (int r = 0; r < 17; ++r) part[((w * 4 + kq) * 17 + r) * 16 + col] = acc[r];
    __syncthreads();
    for (int idx = tid; idx < 17 * 16; idx += 512) { const int r = idx >> 4, l = idx & 15; float sum = bmod[nc * 16 + l];
#pragma unroll
        for (int p = 0; p < 32; ++p) sum += part[(p * 17 + r) * 16 + l];
        MOD[(size_t)r * 3072 + nc * 16 + l] = sum; }
    __syncthreads();
}
__device__ __forceinline__ void p1_rows(const float* x, const float* ctx, const float* normw, const float* MOD, bf16* U, int gw, int NGW, int lane) {
    for (int ch = gw; ch < (M + MC) / 4; ch += NGW) {
        const int row0 = 4 * ch; const bool isc = row0 >= M; const int b = isc ? 16 : (row0 >> 11);
        const float* src = isc ? ctx + (size_t)(row0 - M) * DM : x + (size_t)row0 * DM;
        const float* mp = MOD + (size_t)b * 3072;
        f32x4 g[4], sh[4];
#pragma unroll
        for (int j = 0; j < 4; ++j) { const int col = 4 * lane + 256 * j; const f32x4 nw = *(const f32x4*)(normw + col), scl = *(const f32x4*)(mp + 1024 + col); sh[j] = *(const f32x4*)(mp + col); g[j] = nw * (1.0f + scl); }
        f32x4 vv[4][4];
#pragma unroll
        for (int rr = 0; rr < 4; ++rr) { const f32x4* xr = (const f32x4*)(src + (size_t)rr * DM) + lane;
#pragma unroll
            for (int j = 0; j < 4; ++j) vv[rr][j] = __builtin_nontemporal_load(xr + 64 * j); }
        asm volatile("" ::: "memory");
#pragma unroll
        for (int rr = 0; rr < 4; ++rr) {
            f32x4 v[4]; float s = 0.f;
#pragma unroll
            for (int j = 0; j < 4; ++j) { v[j] = vv[rr][j]; s += (v[j].x * v[j].x + v[j].y * v[j].y) + (v[j].z * v[j].z + v[j].w * v[j].w); }
            const float rinv = rsqrtf(wave_sum(s) * (1.0f / DM) + 1e-6f);
            unsigned long long* o8 = (unsigned long long*)(U + (size_t)(row0 + rr) * DM) + lane;
#pragma unroll
            for (int j = 0; j < 4; ++j) { const f32x4 o = v[j] * rinv * g[j] + sh[j];
                o8[64 * j] = (unsigned long long)pk2(o.x, o.y) | ((unsigned long long)pk2(o.z, o.w) << 32); }
        }
    }
}
__device__ __forceinline__ void conv_phase(LAS unsigned char* lds, const bf16* UG, const float* cw, const float* cb, const float* lnw, const float* lnb, bf16* Y, int vcu, int G, int tid) {
    LAS float* tile = (LAS float*)lds;
    const int cp = tid & 255, th = tid >> 8, wv = tid >> 6, lane = tid & 63;
    f32x2 w[31];
#pragma unroll
    for (int j = 0; j < 31; ++j) w[j] = *(const f32x2*)(cw + j * 512 + 2 * cp);
    const f32x2 bias = *(const f32x2*)(cb + 2 * cp);
    for (int item = vcu; item < M / 32; item += G) {
        const int row0 = item * 32 + th * 16, t0 = row0 & 2047;
        const unsigned* ub = (const unsigned*)(UG + (size_t)(row0 - t0) * 512 + 2 * cp);
        unsigned xr[46];
#pragma unroll
        for (int r = 0; r < 46; ++r) { const int tin = t0 - 15 + r, tc = tin < 0 ? 0 : (tin > 2047 ? 2047 : tin); xr[r] = ub[(size_t)tc * 256]; }
        f32x2 acc[16];
#pragma unroll
        for (int i = 0; i < 16; ++i) acc[i] = (f32x2){0.f, 0.f};
#pragma unroll
        for (int r = 0; r < 46; ++r) {
            const int tin = t0 - 15 + r; const bool ok = (tin >= 0) && (tin < 2048);
            const f32x2 xv = (f32x2){ok ? pg8::bf_lo(xr[r]) : 0.f, ok ? pg8::bf_hi(xr[r]) : 0.f};
#pragma unroll
            for (int i = 0; i < 16; ++i) { const int j = r - i; if (j >= 0 && j <= 30) acc[i] += xv * w[j]; }
        }
#pragma unroll
        for (int i = 0; i < 16; ++i) *(LAS f32x2*)(tile + (th * 16 + i) * 512 + 2 * cp) = acc[i] + bias;
        __syncthreads();
        const f32x4 lw0 = *(const f32x4*)(lnw + 8 * lane), lw1 = *(const f32x4*)(lnw + 8 * lane + 4), lb0 = *(const f32x4*)(lnb + 8 * lane), lb1 = *(const f32x4*)(lnb + 8 * lane + 4);
#pragma unroll
        for (int rr = 0; rr < 4; ++rr) {
            const int row = 4 * wv + rr;
            const f32x4 a = *(const LAS f32x4*)(tile + row * 512 + 8 * lane), b = *(const LAS f32x4*)(tile + row * 512 + 8 * lane + 4);
            const float mean = wave_sum((a.x + a.y) + (a.z + a.w) + (b.x + b.y) + (b.z + b.w)) * (1.0f / 512.0f);
            const f32x4 da = a - mean, db = b - mean;
            const float var = wave_sum((da.x * da.x + da.y * da.y) + (da.z * da.z + da.w * da.w) + (db.x * db.x + db.y * db.y) + (db.z * db.z + db.w * db.w)) * (1.0f / 512.0f);
            const float rstd = rsqrtf(var + 1e-6f);
            const f32x4 ya = da * rstd * lw0 + lb0, yb = db * rstd * lw1 + lb1;
            v4u o; o.x = pk2(pg8::silu_f(ya.x), pg8::silu_f(ya.y)); o.y = pk2(pg8::silu_f(ya.z), pg8::silu_f(ya.w)); o.z = pk2(pg8::silu_f(yb.x), pg8::silu_f(yb.y)); o.w = pk2(pg8::silu_f(yb.z), pg8::silu_f(yb.w));
            *(v4u*)(Y + (size_t)(item * 32 + row) * 512 + 8 * lane) = o;
        }
        __syncthreads();
    }
}

#ifndef MK_N_LAUNCHES
#define MK_N_LAUNCHES 1
#endif
constexpr int N_PHASES = 6;
struct Args { const float* in[17]; float* out; unsigned char* ws; int ph_lo, ph_hi; };
__global__ void __launch_bounds__(NWAVES * 64, 2) hybrid_fwd(Args args) {
    extern __shared__ __attribute__((aligned(16))) unsigned char lds[];
    LAS unsigned char* ldsl = (LAS unsigned char*)lds;
    const int tid = threadIdx.x, lane = tid & 63, wave = __builtin_amdgcn_readfirstlane(tid >> 6);
    const int G = gridDim.x, bx = blockIdx.x, vcu = (G % 8 == 0) ? (bx % 8) * (G / 8) + bx / 8 : bx;
    const int gw = vcu * NWAVES + wave, NGW = G * NWAVES;
    unsigned char* ws = args.ws;
    const float *x = args.in[0], *cvec = args.in[1], *ctx = args.in[2], *cctx = args.in[3], *wmod = args.in[4], *bmod = args.in[5], *normw = args.in[6], *win = args.in[7],
                *qnw = args.in[8], *knw = args.in[9], *convw = args.in[10], *convb = args.in[11], *lnw = args.in[12], *lnb = args.in[13], *wpw = args.in[14], *bpw = args.in[15], *wout = args.in[16];
    float* MOD = (float*)(ws + WS_MOD); float* ROPE = (float*)(ws + WS_ROPE);
    bf16 *WIN_T = (bf16*)(ws + WS_WIN), *WPW_T = (bf16*)(ws + WS_WPW), *WOUT_T = (bf16*)(ws + WS_WOUT), *U = (bf16*)(ws + WS_U), *Q = (bf16*)(ws + WS_Q), *KA = (bf16*)(ws + WS_KA), *VA = (bf16*)(ws + WS_VA),
         *Z = (bf16*)(ws + WS_Z), *UG = (bf16*)(ws + WS_UG), *Y = (bf16*)(ws + WS_Y), *MIX = (bf16*)(ws + WS_MIX);
    const int lo = args.ph_lo, hi = args.ph_hi;
#define IN(k) (lo <= (k) && (k) < hi)
    for (int u = tid; u < (LDS_BYTES - RING_BYTES) / 4; u += NWAVES * 64) ((LAS unsigned*)(ldsl + RING_BYTES))[u] = 0u;
    __syncthreads();
    XcdBarrier bar; bar.bar = (unsigned*)(ws + WS_CTL); bar.x = 0; bar.st = nullptr;
    if (hi - lo > 1) bar = xcd_barrier_post((unsigned*)(ws + WS_CTL), (volatile LAS unsigned*)(ldsl + MISC_OFF) + 8);
    if (lo > 99) cooperative_groups::this_grid().sync();
#define SEAM(k) do { if (IN(k) && IN((k) + 1)) xcd_barrier(bar); } while (0)
#ifndef REPMASK
#define REPMASK 0
#endif
#define REPS(k) for (int rep_ = 0; rep_ < 1 + ((REPMASK >> (k)) & 1); ++rep_)

    if (IN(0)) REPS(0) {
        LAS float* scr = (LAS float*)(ldsl + wave * 16384);
        constexpr int I_IN = (DM / 64) * (DIN / 32), I_PW = (DCONV / 64) * (DCONV / 32), I_OUT = (DM / 64) * (DM / 32);
        for (int it = gw; it < I_IN + I_PW + I_OUT; it += NGW) {
            int r = it;
            if (r < I_IN) { p0_transpose_item<true>(win, DM, DIN, WIN_T, scr, r, lane); continue; } r -= I_IN;
            if (r < I_PW) { p0_transpose_item<false>(wpw, DCONV, DCONV, WPW_T, scr, r, lane); continue; } r -= I_PW;
            p0_transpose_item<false>(wout, DM, DM, WOUT_T, scr, r, lane);
        }
        { const int gt = bx * 512 + tid;
          if (gt < 1024) { const int pos = gt >> 4, f = gt & 15; const float freq = powf(10000.0f, -(float)f * (1.0f / 16.0f)); const float ang = (float)pos * freq;
              ROPE[2 * gt] = cosf(ang); ROPE[2 * gt + 1] = sinf(ang); } }
        __syncthreads();
        for (int nc = bx; nc < 192; nc += G) mod_item(ldsl, cvec, cctx, wmod, bmod, MOD, nc, tid);
    }
    SEAM(0);
    if (IN(1)) REPS(1) p1_rows(x, ctx, normw, MOD, U, gw, NGW, lane);
    SEAM(1);
    if (IN(2)) REPS(2) {
        pg8::Gemm g{U, WIN_T, M + MC, DIN, DM}; pg8::OrderIn S; S.init(G, bx);
        pg8::EpiIn E{Q, KA, VA, Z, UG, ROPE, qnw, knw};
        pg8::gemm_phase<pg8::EpiIn, pg8::OrderIn, true, true>(ldsl, g, S, E);
    }
    SEAM(2);
    if (IN(3)) REPS(3) conv_phase(ldsl, UG, convw, convb, lnw, lnb, Y, vcu, G, tid);
    SEAM(3);
    if (IN(4)) REPS(4) {
        const attn_body::AttnTensors AT{(const attn_body::bf16*)Q, (const attn_body::bf16*)KA, (const attn_body::bf16*)VA, (const attn_body::bf16*)Z, (attn_body::bf16*)MIX};
        float mq = 0.f, mk = 0.f;
        for (int d = 0; d < 64; ++d) { mq = fmaxf(mq, fabsf(qnw[d])); mk = fmaxf(mk, fabsf(knw[d])); }
        const float mfix = 1.02f * 64.0f * pg8::QC2 * mq * mk;
        if (mfix <= 60.0f) attn_body::attn_phase<8, true>((char*)lds, AT, vcu, G, mfix);
        else               attn_body::attn_phase<8, false>((char*)lds, AT, vcu, G, 0.f);
        pg8::Gemm g{Y, WPW_T, M, DCONV, DCONV}; pg8::StaticOrder S; S.init(M, DCONV, G, bx);
        pg8::EpiPw E{Z, MIX, bpw};
        pg8::gemm_phase<pg8::EpiPw, pg8::StaticOrder, true, true>(ldsl, g, S, E);
    }
    SEAM(4);
    if (IN(5)) REPS(5) {
        pg8::Gemm g{MIX, WOUT_T, M, DM, DM}; pg8::StaticOrder S; S.init(M, DM, G, bx);
        pg8::EpiOut E{x, args.out, MOD};
        pg8::gemm_phase<pg8::EpiOut, pg8::StaticOrder, true, true>(ldsl, g, S, E);
    }
#undef IN
#undef SEAM
}

extern "C" void kernel_launch(void* const* d_in, const int* in_sizes, int n_in, void* d_out, int out_size, void* d_ws, size_t ws_size, hipStream_t stream) {
    static int grid = 0;
    if (grid == 0) {
        if (n_in != 17 || in_sizes[0] != M * DM || out_size != M * DM || ws_size < WS_END) { fprintf(stderr, "kernel_launch: unexpected shapes (n_in %d, in0 %d, out %d, ws %zu); nothing launched\n", n_in, n_in > 0 ? in_sizes[0] : -1, out_size, ws_size); grid = -1; return; }
        int dev = 0, cus = 0, per_cu = 0;
        if (hipGetDevice(&dev) != hipSuccess || hipDeviceGetAttribute(&cus, hipDeviceAttributeMultiprocessorCount, dev) != hipSuccess) { grid = -1; return; }
        if (hipFuncSetAttribute((const void*)hybrid_fwd, hipFuncAttributeMaxDynamicSharedMemorySize, LDS_BYTES) != hipSuccess) { fprintf(stderr, "kernel_launch: hipFuncSetAttribute failed\n"); grid = -1; return; }
        if (hipOccupancyMaxActiveBlocksPerMultiprocessor(&per_cu, (const void*)hybrid_fwd, NWAVES * 64, LDS_BYTES) != hipSuccess || per_cu < 1) { fprintf(stderr, "kernel_launch: occupancy query says %d\n", per_cu); per_cu = 1; }
        (void)hipGetLastError();
        grid = cus * per_cu;
    }
    if (grid < 0) return;
    if (hipMemsetAsync((char*)d_ws + WS_CTL, 0, CTL_ZERO_BYTES, stream) != hipSuccess) { fprintf(stderr, "kernel_launch: memset failed\n"); return; }
    Args a{};
    for (int i = 0; i < 17; ++i) a.in[i] = (const float*)d_in[i];
    a.out = (float*)d_out; a.ws = (unsigned char*)d_ws;
#if MK_N_LAUNCHES == 1
    a.ph_lo = 0; a.ph_hi = N_PHASES;
    void* kargs[] = {&a};
    hipError_t e = hipLaunchCooperativeKernel((const void*)hybrid_fwd, dim3(grid), dim3(NWAVES * 64), kargs, LDS_BYTES, stream);
    if (e != hipSuccess) fprintf(stderr, "kernel_launch: cooperative launch failed: %s (grid %d)\n", hipGetErrorString(e), grid);
#else
    for (int p = 0; p < N_PHASES; ++p) { a.ph_lo = p; a.ph_hi = p + 1; hipLaunchKernelGGL(hybrid_fwd, dim3(grid), dim3(NWAVES * 64), LDS_BYTES, stream, a); }
#endif
}
```

```cpp
#include <hip/hip_runtime.h>
#include <hip/hip_cooperative_groups.h>
#include <cstdio>
#include <cstdint>
namespace pg8 {
#define PG8_LAS __attribute__((address_space(3)))
typedef unsigned short bf16_t;
typedef short bf16x8 __attribute__((ext_vector_type(8)));
typedef float f32x4 __attribute__((ext_vector_type(4)));
typedef unsigned u32x4 __attribute__((ext_vector_type(4)));
constexpr int BM = 256, BK = 64, HALF = 128, HTB = HALF * BK * 2  , STAGE_BYTES = 8 * HTB, NXCD = 8, WGM = 8;

__host__ __device__ __forceinline__ int lds_byte(int r, int c) { const int st = (r >> 4) * 2 + (c >> 5), rr = r & 15, cc = c & 31, ob = rr * 64 + cc * 2; return st * 1024 + (ob ^ (((ob >> 9) & 1) << 5)); }
__host__ __device__ __forceinline__ void stage_rc(int b, int& R, int& C) { const int st = b / 1024, sb = b % 1024, swz = sb ^ (((sb >> 9) & 1) << 5); R = (st >> 1) * 16 + swz / 64; C = (st & 1) * 32 + (swz % 64) / 2; }
__host__ __device__ __forceinline__ int perm32(int rho) { const int n = rho >> 4, i = rho & 15; return 8 * (i >> 2) + 4 * n + (i & 3); }

struct Unit { int pm, pn; };
struct Gemm { const bf16_t* A; const bf16_t* Bt; int M, N, K; };

struct StaticOrder {
    int nM, nN, nwg, G, c;
    __host__ __device__ void init(int M, int N, int G_, int c_) { nM = M / BM; nN = N / BM; nwg = nM * nN; G = G_; c = c_; }
    __host__ __device__ bool next(int i, Unit& u) const {
        const long L = (long)i * G + c; if (L >= nwg) return false;
        int wgid = (int)L; { const int q = nwg / NXCD, r = nwg % NXCD, xcd = wgid % NXCD, off = wgid / NXCD; wgid = (xcd < r ? xcd * (q + 1) : r * (q + 1) + (xcd - r) * q) + off; }
        const int nig = WGM * nN, gid = wgid / nig, fm = gid * WGM, gsz = (nM - fm) < WGM ? (nM - fm) : WGM;
        u.pm = fm + ((wgid % nig) % gsz); u.pn = (wgid % nig) / gsz; return true;
    }
    __device__ __forceinline__ void a_ready(const Unit&) const {}
    __device__ __forceinline__ void done(const Unit&) const {}
};
__device__ __forceinline__ unsigned cvt_pk_bf16(float lo, float hi) { unsigned r; asm volatile("v_cvt_pk_bf16_f32 %0, %1, %2" : "=v"(r) : "v"(lo), "v"(hi)); return r; }
typedef float f32x2 __attribute__((ext_vector_type(2)));
constexpr float QC2 = 0.125f * 1.4426950408889634f;
__device__ __forceinline__ float silu_f(float v) { return v * __builtin_amdgcn_rcpf(1.0f + __expf(-v)); }
__device__ __forceinline__ float sigm_f(float v) { return __builtin_amdgcn_rcpf(1.0f + __expf(-v)); }
__device__ __forceinline__ float bf_lo(unsigned w) { return __uint_as_float(w << 16); }
__device__ __forceinline__ float bf_hi(unsigned w) { return __uint_as_float(w & 0xffff0000u); }

struct OrderIn {
    StaticOrder so;
    __device__ void init(int G_, int c_) { so.init(32768, 2816, G_, c_); }
    __device__ bool next(int i, Unit& u) const {
        const long L = (long)i * so.G + so.c;
        if (L < so.nwg) return so.next(i, u);
        const int e = (int)(L - so.nwg); if (e >= 16) return false;
        u.pm = 128 + e; u.pn = 2; return true;
    }
    __device__ __forceinline__ void a_ready(const Unit&) const {}
    __device__ __forceinline__ void done(const Unit&) const {}
};

struct EpiIn {
    static constexpr bool PERM = true, AFTER_DRAIN = false;
    bf16_t *Q, *KA, *VA, *Z, *UG; const float* rope; const float *qnw, *knw;
    __device__ __forceinline__ void operator()(const f32x4 (&acc)[2][2][4][2], const Unit& u, int wr, int wc, int fr, int fq) const {
        const int pn = u.pn;
        const int rowb = u.pm * BM + wr * 64 + fr;
        if (pn <= 2) {
            const bool isq = pn < 2, isv = (pn == 2) && (wc >= 2), isctx = u.pm >= 128;
            const int d1 = (fq & 1) * 8 + (fq >> 1) * 32;
            float w1[8], w2[8];
            { const float* nw = isq ? qnw : knw; const float sc = isq ? QC2 : 1.0f;
#pragma unroll
              for (int e = 0; e < 8; ++e) { w1[e] = nw[d1 + e] * sc; w2[e] = nw[d1 + 16 + e] * sc; } }
#pragma unroll
            for (int ai = 0; ai < 2; ++ai)
#pragma unroll
                for (int m = 0; m < 4; ++m) {
                    const int row = rowb + ai * HALF + m * 16;
                    float x1[8], x2[8];
#pragma unroll
                    for (int n = 0; n < 2; ++n)
#pragma unroll
                        for (int i = 0; i < 4; ++i) { x1[4 * n + i] = acc[ai][0][m][n][i]; x2[4 * n + i] = acc[ai][1][m][n][i]; }
                    bf16_t* dst;
                    if (isq) dst = Q + (size_t)row * 512 + (4 * pn + wc) * 64 + d1;
                    else {
                        size_t pos;
                        if (isctx) { const int r2 = row - 32768; pos = (size_t)(r2 >> 8) * 2304 + (r2 & 255); }
                        else pos = (size_t)(row >> 11) * 2304 + 256 + (row & 2047);
                        dst = (isv ? VA : KA) + pos * 128 + (wc & 1) * 64 + d1;
                    }
                    if (!isv) {
                        float ss = 0.f;
#pragma unroll
                        for (int e = 0; e < 8; ++e) ss += x1[e] * x1[e] + x2[e] * x2[e];
                        ss += __shfl_xor(ss, 16); ss += __shfl_xor(ss, 32);
                        const float rinv = rsqrtf(ss * (1.0f / 64.0f) + 1e-6f);
#pragma unroll
                        for (int e = 0; e < 8; ++e) { x1[e] = x1[e] * rinv * w1[e]; x2[e] = x2[e] * rinv * w2[e]; }
                        if (!isctx) {
                            const int t = row & 2047, pos = (fq >> 1) ? (t & 63) : (t >> 6);
                            const f32x4* rp = (const f32x4*)(rope + (size_t)(pos * 16 + (fq & 1) * 8) * 2);
#pragma unroll
                            for (int e2 = 0; e2 < 4; ++e2) { const f32x4 cs = rp[e2];
                                { const float a = x1[2 * e2], b = x2[2 * e2]; x1[2 * e2] = a * cs[0] - b * cs[1]; x2[2 * e2] = a * cs[1] + b * cs[0]; }
                                { const float a = x1[2 * e2 + 1], b = x2[2 * e2 + 1]; x1[2 * e2 + 1] = a * cs[2] - b * cs[3]; x2[2 * e2 + 1] = a * cs[3] + b * cs[2]; } }
                        }
                    }
                    u32x4 o1, o2;
                    o1.x = cvt_pk_bf16(x1[0], x1[1]); o1.y = cvt_pk_bf16(x1[2], x1[3]); o1.z = cvt_pk_bf16(x1[4], x1[5]); o1.w = cvt_pk_bf16(x1[6], x1[7]);
                    o2.x = cvt_pk_bf16(x2[0], x2[1]); o2.y = cvt_pk_bf16(x2[2], x2[3]); o2.z = cvt_pk_bf16(x2[4], x2[5]); o2.w = cvt_pk_bf16(x2[6], x2[7]);
                    *(u32x4*)dst = o1; *(u32x4*)(dst + 16) = o2;
                }
        } else if (pn >= 5 && pn <= 8) {
            const int c0 = (pn - 5) * 128 + wc * 32 + 8 * fq;
#pragma unroll
            for (int ai = 0; ai < 2; ++ai)
#pragma unroll
                for (int m = 0; m < 4; ++m) {
                    const int row = rowb + ai * HALF + m * 16;
                    const f32x4 a0 = acc[ai][0][m][0], a1 = acc[ai][0][m][1], g0 = acc[ai][1][m][0], g1 = acc[ai][1][m][1];
                    u32x4 w;
                    w.x = cvt_pk_bf16(a0[0] * sigm_f(g0[0]), a0[1] * sigm_f(g0[1])); w.y = cvt_pk_bf16(a0[2] * sigm_f(g0[2]), a0[3] * sigm_f(g0[3]));
                    w.z = cvt_pk_bf16(a1[0] * sigm_f(g1[0]), a1[1] * sigm_f(g1[1])); w.w = cvt_pk_bf16(a1[2] * sigm_f(g1[2]), a1[3] * sigm_f(g1[3]));
                    *(u32x4*)(UG + (size_t)row * 512 + c0) = w;
                }
        } else {
            const int zc = (pn <= 4 ? (pn - 3) * 256 : 512 + (pn - 9) * 256) + wc * 32 + 8 * fq;
#pragma unroll
            for (int ai = 0; ai < 2; ++ai)
#pragma unroll
                for (int m = 0; m < 4; ++m) {
                    const int row = rowb + ai * HALF + m * 16;
#pragma unroll
                    for (int bj = 0; bj < 2; ++bj) { const f32x4 v0 = acc[ai][bj][m][0], v1 = acc[ai][bj][m][1];
                        u32x4 w; w.x = cvt_pk_bf16(silu_f(v0[0]), silu_f(v0[1])); w.y = cvt_pk_bf16(silu_f(v0[2]), silu_f(v0[3]));
                        w.z = cvt_pk_bf16(silu_f(v1[0]), silu_f(v1[1])); w.w = cvt_pk_bf16(silu_f(v1[2]), silu_f(v1[3]));
                        *(u32x4*)(Z + (size_t)row * 1024 + zc + bj * HALF) = w; }
                }
        }
    }
};

struct EpiPw {
    static constexpr bool PERM = true, AFTER_DRAIN = false;
    const bf16_t* Z; bf16_t* MIX; const float* bias;
    __device__ __forceinline__ void operator()(const f32x4 (&acc)[2][2][4][2], const Unit& u, int wr, int wc, int fr, int fq) const {
        const int rowb = u.pm * BM + wr * 64 + fr, col0 = u.pn * BM + wc * 32 + 8 * fq;
        f32x4 bv[2][2];
#pragma unroll
        for (int bj = 0; bj < 2; ++bj)
#pragma unroll
            for (int n = 0; n < 2; ++n) bv[bj][n] = *(const f32x4*)(bias + col0 + bj * HALF + 4 * n);
        u32x4 zz[2][4][2];
#pragma unroll
        for (int ai = 0; ai < 2; ++ai)
#pragma unroll
            for (int m = 0; m < 4; ++m) { const size_t off = (size_t)(rowb + ai * HALF + m * 16) * 1024 + 512 + col0;
#pragma unroll
                for (int bj = 0; bj < 2; ++bj) zz[ai][m][bj] = *(const u32x4*)(Z + off + bj * HALF); }
        asm volatile("" ::: "memory");
#pragma unroll
        for (int ai = 0; ai < 2; ++ai)
#pragma unroll
            for (int m = 0; m < 4; ++m) {
                const size_t off = (size_t)(rowb + ai * HALF + m * 16) * 1024 + 512 + col0;
#pragma unroll
                for (int bj = 0; bj < 2; ++bj) {
                    const u32x4 z = zz[ai][m][bj];
                    const f32x4 v0 = acc[ai][bj][m][0] + bv[bj][0], v1 = acc[ai][bj][m][1] + bv[bj][1];
                    u32x4 w;
                    w.x = cvt_pk_bf16(v0[0] * bf_lo(z.x), v0[1] * bf_hi(z.x)); w.y = cvt_pk_bf16(v0[2] * bf_lo(z.y), v0[3] * bf_hi(z.y));
                    w.z = cvt_pk_bf16(v1[0] * bf_lo(z.z), v1[1] * bf_hi(z.z)); w.w = cvt_pk_bf16(v1[2] * bf_lo(z.w), v1[3] * bf_hi(z.w));
                    *(u32x4*)(MIX + off + bj * HALF) = w;
                }
            }
    }
};

struct EpiOut {
    static constexpr bool PERM = false, AFTER_DRAIN = false;
    const float* x; float* out; const float* mod;
    __device__ __forceinline__ void operator()(const f32x4 (&acc)[2][2][4][2], const Unit& u, int wr, int wc, int fr, int fq) const {
        const int rowb = u.pm * BM + wr * 64 + fr, col0 = u.pn * BM + wc * 32 + 4 * fq;
        const float* gp = mod + (size_t)(u.pm >> 3) * 3072 + 2048 + col0;
        f32x4 gv[2][2];
#pragma unroll
        for (int bj = 0; bj < 2; ++bj)
#pragma unroll
            for (int n = 0; n < 2; ++n) gv[bj][n] = *(const f32x4*)(gp + bj * HALF + n * 16);
        const float* __restrict__ xr_ = x; float* __restrict__ or_ = out;
#pragma unroll
        for (int ai = 0; ai < 2; ++ai) {
            f32x4 xv[4][2][2];
#pragma unroll
            for (int m = 0; m < 4; ++m) { const size_t off = (size_t)(rowb + ai * HALF + m * 16) * 1024 + col0;
#pragma unroll
                for (int bj = 0; bj < 2; ++bj)
#pragma unroll
                    for (int n = 0; n < 2; ++n) xv[m][bj][n] = *(const f32x4*)(xr_ + off + bj * HALF + n * 16); }
            asm volatile("" ::: "memory");
#pragma unroll
            for (int m = 0; m < 4; ++m) { const size_t off = (size_t)(rowb + ai * HALF + m * 16) * 1024 + col0;
#pragma unroll
                for (int bj = 0; bj < 2; ++bj)
#pragma unroll
                    for (int n = 0; n < 2; ++n) *(f32x4*)(or_ + off + bj * HALF + n * 16) = xv[m][bj][n] + gv[bj][n] * acc[ai][bj][m][n]; }
            asm volatile("" ::: "memory");
        }
    }
};
template <class Epi, class Sched, bool ALIGN_EPI = false, bool SP2 = false>
__device__ __forceinline__ void gemm_phase(PG8_LAS unsigned char* lds, const Gemm g, const Sched& S, const Epi& E) {
    const int tid = threadIdx.x, wid = __builtin_amdgcn_readfirstlane(tid >> 6), lane = tid & 63, wr = wid >> 2, wc = wid & 3, fr = lane & 15, fq = lane >> 4;
    const int K = g.K, nt = K / BK;
    unsigned voffA[2], voffB[2];
#pragma unroll
    for (int i = 0; i < 2; ++i) { int R, C; stage_rc(tid * 16 + i * 8192, R, C); const int Rb = Epi::PERM ? ((R & ~31) + perm32(R & 31)) : R;
        voffA[i] = (unsigned)(R * K + C) * 2u; voffB[i] = (unsigned)(Rb * K + C) * 2u; }
    const size_t kstep = (size_t)(BK * 2);
    const size_t hstep = (size_t)HALF * K * 2;
    const size_t tstep = 2 * hstep;
    const unsigned ldsw = (unsigned)wid * 1024u;
    const int aoff = lds_byte(wr * 64 + fr, fq * 8), boff = lds_byte(wc * 32 + fr, fq * 8);
#define PG8_SA(b, h) (((b) * 2 + (h)) * HTB)
#define PG8_SB(b, h) ((4 + (b) * 2 + (h)) * HTB)
#define PG8_STAGE(bufoff, gbase, voff) do { _Pragma("unroll") for (int _i = 0; _i < 2; ++_i) \
        __builtin_amdgcn_global_load_lds((const unsigned*)((const char*)(gbase) + (voff)[_i]), (PG8_LAS unsigned*)(lds + (bufoff) + ldsw + _i * 8192), 16, 0, 0); } while (0)
#define PG8_LDA(dst, b, h) do { _Pragma("unroll") for (int m = 0; m < 4; ++m) _Pragma("unroll") for (int k = 0; k < 2; ++k) dst[m][k] = *(const PG8_LAS bf16x8*)(lds + PG8_SA(b, h) + aoff + m * 2048 + k * 1024); } while (0)
#define PG8_LDB(dst, b, h) do { _Pragma("unroll") for (int n = 0; n < 2; ++n) _Pragma("unroll") for (int k = 0; k < 2; ++k) dst[n][k] = *(const PG8_LAS bf16x8*)(lds + PG8_SB(b, h) + boff + n * 2048 + k * 1024); } while (0)
#define PG8_MMA(ai, bj, At, Bt) do { __builtin_amdgcn_s_setprio(1); _Pragma("unroll") for (int m = 0; m < 4; ++m) _Pragma("unroll") for (int n = 0; n < 2; ++n) _Pragma("unroll") for (int k = 0; k < 2; ++k) \
        acc[ai][bj][m][n] = __builtin_amdgcn_mfma_f32_16x16x32_bf16(Bt[n][k], At[m][k], acc[ai][bj][m][n], 0, 0, 0); __builtin_amdgcn_s_setprio(0); } while (0)
#define PG8_WAIT_V(n) asm volatile("s_waitcnt vmcnt(" #n ")" ::: "memory")
#define PG8_WAIT_L(n) asm volatile("s_waitcnt lgkmcnt(" #n ")" ::: "memory")
#define PG8_BAR __builtin_amdgcn_s_barrier()
#define PG8_SCHED __builtin_amdgcn_sched_barrier(0)
    Unit cur, nxt; int ui = 0;
    if (!S.next(0, cur)) return;
    f32x4 acc[2][2][4][2];
#pragma unroll
    for (int a = 0; a < 2; ++a)
#pragma unroll
        for (int b = 0; b < 2; ++b)
#pragma unroll
            for (int m = 0; m < 4; ++m)
#pragma unroll
                for (int n = 0; n < 2; ++n) acc[a][b][m][n] = (f32x4){0.f, 0.f, 0.f, 0.f};
    bf16x8 At[4][2], B0[2][2], B1[2][2];
    const char* cA = (const char*)g.A + (size_t)cur.pm * tstep; const char* cB = (const char*)g.Bt + (size_t)cur.pn * tstep;
    S.a_ready(cur);
    if constexpr (SP2) {
        PG8_STAGE(PG8_SB(0, 0), cB, voffB); PG8_STAGE(PG8_SB(0, 1), cB + hstep, voffB); PG8_STAGE(PG8_SA(0, 0), cA, voffA); PG8_STAGE(PG8_SA(0, 1), cA + hstep, voffA);
        if (wr == 1) PG8_BAR;
        PG8_WAIT_V(2); PG8_BAR;
        PG8_STAGE(PG8_SB(1, 0), cB + kstep, voffB); PG8_STAGE(PG8_SA(1, 0), cA + kstep, voffA); PG8_STAGE(PG8_SB(1, 1), cB + hstep + kstep, voffB);
        PG8_WAIT_V(6); PG8_BAR;
    } else {
        PG8_STAGE(PG8_SB(0, 0), cB, voffB); PG8_STAGE(PG8_SA(0, 0), cA, voffA); PG8_STAGE(PG8_SB(0, 1), cB + hstep, voffB); PG8_STAGE(PG8_SA(0, 1), cA + hstep, voffA);
        if (wr == 1) PG8_BAR;
        PG8_WAIT_V(4); PG8_BAR;
        PG8_STAGE(PG8_SB(1, 0), cB + kstep, voffB); PG8_STAGE(PG8_SA(1, 0), cA + kstep, voffA); PG8_STAGE(PG8_SB(1, 1), cB + hstep + kstep, voffB);
        PG8_WAIT_V(6); PG8_BAR;
    }
    for (;;) {
        const bool has_next = S.next(ui + 1, nxt);
        const char* nA = has_next ? (const char*)g.A + (size_t)nxt.pm * tstep : cA; const char* nB = has_next ? (const char*)g.Bt + (size_t)nxt.pn * tstep : cB;
        for (int t = 0; t < nt; t += 2) {
            const bool last = (t == nt - 2);
            const char* a1 = cA + (size_t)(t + 1) * kstep;
            const char* a2 = last ? nA : cA + (size_t)(t + 2) * kstep; const char* b2 = last ? nB : cB + (size_t)(t + 2) * kstep;
            const char* a3 = a2 + kstep; const char* b3 = b2 + kstep;
            if (last && has_next) S.a_ready(nxt);
            if constexpr (SP2) {
            PG8_LDB(B0, 0, 0); PG8_LDB(B1, 0, 1); PG8_SCHED; PG8_LDA(At, 0, 0); PG8_STAGE(PG8_SA(1, 1), a1 + hstep, voffA);
            PG8_WAIT_V(8); PG8_WAIT_L(0); PG8_BAR; PG8_MMA(0, 0, At, B0); PG8_MMA(0, 1, At, B1); PG8_BAR; PG8_SCHED;
            PG8_LDA(At, 0, 1); PG8_STAGE(PG8_SB(0, 0), b2, voffB); PG8_STAGE(PG8_SB(0, 1), b2 + hstep, voffB); PG8_STAGE(PG8_SA(0, 0), a2, voffA);
            PG8_WAIT_V(8); PG8_WAIT_L(0); PG8_BAR; PG8_MMA(1, 0, At, B0); PG8_MMA(1, 1, At, B1); PG8_BAR; PG8_SCHED;
            PG8_LDB(B0, 1, 0); PG8_LDB(B1, 1, 1); PG8_SCHED; PG8_LDA(At, 1, 0); PG8_STAGE(PG8_SA(0, 1), a2 + hstep, voffA);
            PG8_WAIT_V(8); PG8_WAIT_L(0); PG8_BAR; PG8_MMA(0, 0, At, B0); PG8_MMA(0, 1, At, B1); PG8_BAR; PG8_SCHED;
            PG8_LDA(At, 1, 1); PG8_STAGE(PG8_SB(1, 0), b3, voffB); PG8_STAGE(PG8_SB(1, 1), b3 + hstep, voffB); PG8_STAGE(PG8_SA(1, 0), a3, voffA);
            PG8_WAIT_V(8); PG8_WAIT_L(0); PG8_BAR; PG8_MMA(1, 0, At, B0); PG8_MMA(1, 1, At, B1); PG8_BAR; PG8_SCHED;
            } else {
            PG8_LDB(B0, 0, 0); PG8_SCHED; PG8_LDA(At, 0, 0); PG8_STAGE(PG8_SA(1, 1), a1 + hstep, voffA);
            PG8_WAIT_L(8); PG8_BAR; PG8_WAIT_L(0); PG8_MMA(0, 0, At, B0); PG8_BAR; PG8_SCHED;
            PG8_LDB(B1, 0, 1); PG8_STAGE(PG8_SB(0, 0), b2, voffB);
            PG8_BAR; PG8_WAIT_L(0); PG8_MMA(0, 1, At, B1); PG8_BAR;
            PG8_LDA(At, 0, 1); PG8_STAGE(PG8_SA(0, 0), a2, voffA);
            PG8_BAR; PG8_WAIT_L(0); PG8_MMA(1, 0, At, B0); PG8_BAR; PG8_SCHED;
            PG8_STAGE(PG8_SB(0, 1), b2 + hstep, voffB);
            PG8_WAIT_V(6); PG8_BAR; PG8_MMA(1, 1, At, B1); PG8_BAR;
            PG8_LDB(B0, 1, 0); PG8_SCHED; PG8_LDA(At, 1, 0); PG8_STAGE(PG8_SA(0, 1), a2 + hstep, voffA);
            PG8_WAIT_L(8); PG8_BAR; PG8_WAIT_L(0); PG8_MMA(0, 0, At, B0); PG8_BAR; PG8_SCHED;
            PG8_LDB(B1, 1, 1); PG8_STAGE(PG8_SB(1, 0), b3, voffB);
            PG8_BAR; PG8_WAIT_L(0); PG8_MMA(0, 1, At, B1); PG8_BAR;
            PG8_LDA(At, 1, 1); PG8_STAGE(PG8_SA(1, 0), a3, voffA);
            PG8_BAR; PG8_WAIT_L(0); PG8_MMA(1, 0, At, B0); PG8_BAR; PG8_SCHED;
            PG8_STAGE(PG8_SB(1, 1), b3 + hstep, voffB);
            PG8_WAIT_V(6); PG8_BAR; PG8_MMA(1, 1, At, B1); PG8_BAR;
            }
        }
        if constexpr (ALIGN_EPI) { if (wr == 0) PG8_BAR; }
        if constexpr (!Epi::AFTER_DRAIN) { E(acc, cur, wr, wc, fr, fq); S.done(cur); }
        if (!has_next) break;
#pragma unroll
        for (int a = 0; a < 2; ++a)
#pragma unroll
            for (int b = 0; b < 2; ++b)
#pragma unroll
                for (int m = 0; m < 4; ++m)
#pragma unroll
                    for (int n = 0; n < 2; ++n) acc[a][b][m][n] = (f32x4){0.f, 0.f, 0.f, 0.f};
        cur = nxt; cA = nA; cB = nB; ++ui;
        if constexpr (ALIGN_EPI) { if (wr == 1) PG8_BAR; }
    }
    PG8_WAIT_V(0);
    if constexpr (!ALIGN_EPI) { if (wr == 0) PG8_BAR; }
    PG8_BAR;
    if constexpr (Epi::AFTER_DRAIN) { E.fused(acc, cur, wr, wc, fr, fq, lds, wid, lane); S.done(cur); }
#undef PG8_SA
#undef PG8_SB
#undef PG8_STAGE
#undef PG8_LDA
#undef PG8_LDB
#undef PG8_MMA
#undef PG8_WAIT_V
#undef PG8_WAIT_L
#undef PG8_BAR
#undef PG8_SCHED
}
}
#include <hip/hip_bf16.h>
#include <cmath>
namespace attn_body {
using bf16=__hip_bfloat16;
using bf16x8=__attribute__((ext_vector_type(8)))short;
using s16x4=__attribute__((ext_vector_type(4)))short;
using f32x16=__attribute__((ext_vector_type(16)))float;
using u32x4=__attribute__((ext_vector_type(4)))unsigned;
constexpr int SEQ=2048,SKV=2304,D=64,QP=512,KP=128,OP=1024;
constexpr int NW=8,QBLK=32,QB=QBLK*NW,KVBLK=64,NQB=SEQ/QB;
constexpr int ATTN_UNIT_ROWS=QB;
__device__ __forceinline__ int crow(int r,int hi){return (r&3)+8*(r>>2)+4*hi;}
#define SBAR() __builtin_amdgcn_sched_barrier(0)
__device__ __forceinline__ void cmask(f32x16&p0,f32x16&p1,int jb,int qrel,int hi){
  const float NEG=-INFINITY; int kb=64*jb+4*hi;
  #pragma unroll
  for(int r=0;r<16;++r){int kv=kb+(r&3)+8*(r>>2); if(kv>qrel)p0[r]=NEG; if(kv+32>qrel)p1[r]=NEG;}
}

constexpr int NSLOT=3, SLOTB=8192;
constexpr int LDS_K=0, LDS_V=NSLOT*SLOTB, LDS_WS=2*NSLOT*SLOTB, LDS_OST=LDS_WS+NW*64*4, LDS_BYTES=LDS_OST+NW*4096;
constexpr float C2=0.125f*1.4426950408889634f;
__device__ __forceinline__ void glds16(const void*gsrc,unsigned lds_dst){unsigned keep;
  asm volatile("s_mov_b32 %0, m0\n\ts_mov_b32 m0, %2\n\ts_nop 0\n\tglobal_load_lds_dwordx4 %1, off\n\ts_mov_b32 m0, %0":"=&s"(keep):"v"(gsrc),"s"(lds_dst):"memory");}
__device__ __forceinline__ float max3f(float a,float b,float c){float r;asm("v_max3_f32 %0, %1, %2, %3":"=v"(r):"v"(a),"v"(b),"v"(c));return r;}
__device__ __forceinline__ float max2f(float a,float b){float r;asm("v_max_f32_e32 %0, %1, %2":"=v"(r):"v"(a),"v"(b));return r;}
__device__ __forceinline__ float fadd_s(float a,float b){float r;asm("v_add_f32_e32 %0, %1, %2":"=v"(r):"v"(a),"v"(b));return r;}
__device__ __forceinline__ float fsub_s(float a,float b){float r;asm("v_sub_f32_e32 %0, %1, %2":"=v"(r):"v"(a),"v"(b));return r;}
typedef float f32x2_t __attribute__((ext_vector_type(2))); typedef __bf16 bf16x2_t __attribute__((ext_vector_type(2)));
__device__ __forceinline__ unsigned cvtpk_s(float lo,float hi){f32x2_t v={lo,hi};bf16x2_t b=__builtin_convertvector(v,bf16x2_t);return __builtin_bit_cast(unsigned,b);}
#define WAIT_BAR(N) asm volatile("s_waitcnt vmcnt(" #N ") lgkmcnt(0)\n\ts_barrier":::"memory")

__device__ __forceinline__ void qkt(f32x16&p0,f32x16&p1,const char*Kslot,const bf16x8*qr,const f32x16&negm,int r32,int hi){
  const char*kb=Kslot+hi*1024+r32*16;
  #pragma unroll
  for(int d0=0;d0<4;++d0){
    const bf16x8 b0=*reinterpret_cast<const bf16x8*>(kb+d0*2048);
    const bf16x8 b1=*reinterpret_cast<const bf16x8*>(kb+d0*2048+512);
    if(d0==0){p0=__builtin_amdgcn_mfma_f32_32x32x16_bf16(b0,qr[0],negm,0,0,0);p1=__builtin_amdgcn_mfma_f32_32x32x16_bf16(b1,qr[0],negm,0,0,0);}
    else{p0=__builtin_amdgcn_mfma_f32_32x32x16_bf16(b0,qr[d0],p0,0,0,0);p1=__builtin_amdgcn_mfma_f32_32x32x16_bf16(b1,qr[d0],p1,0,0,0);}}
}
typedef __attribute__((address_space(3))) const char* lds_cptr;
typedef short v4i16_t __attribute__((ext_vector_type(4)));
__device__ __forceinline__ void kload8(bf16x8*kf,lds_cptr kp){
  kf[0]=*(const __attribute__((address_space(3))) bf16x8*)(kp);      kf[1]=*(const __attribute__((address_space(3))) bf16x8*)(kp+512);
  kf[2]=*(const __attribute__((address_space(3))) bf16x8*)(kp+2048); kf[3]=*(const __attribute__((address_space(3))) bf16x8*)(kp+2560);
  kf[4]=*(const __attribute__((address_space(3))) bf16x8*)(kp+4096); kf[5]=*(const __attribute__((address_space(3))) bf16x8*)(kp+4608);
  kf[6]=*(const __attribute__((address_space(3))) bf16x8*)(kp+6144); kf[7]=*(const __attribute__((address_space(3))) bf16x8*)(kp+6656);
}
__device__ __forceinline__ void kload2(bf16x8*kf,lds_cptr kp,int j){ kf[2*j]=*(const __attribute__((address_space(3))) bf16x8*)(kp+j*2048); kf[2*j+1]=*(const __attribute__((address_space(3))) bf16x8*)(kp+j*2048+512); }
__device__ __forceinline__ s16x4 vtr(lds_cptr p){ return __builtin_bit_cast(s16x4,__builtin_amdgcn_ds_read_tr16_b64_v4i16((__attribute__((address_space(3))) v4i16_t*)p)); }
__device__ __forceinline__ float rowmax(const f32x16&p0,const f32x16&p1){
  float a=max3f(p0[0],p0[1],p1[0]),b=max3f(p0[2],p0[3],p1[1]);a=max3f(a,p1[2],p1[3]);
  #pragma unroll
  for(int r=4;r<16;r+=4){a=max3f(a,p0[r],p0[r+1]);b=max3f(b,p0[r+2],p0[r+3]);a=max3f(a,p1[r],p1[r+1]);b=max3f(b,p1[r+2],p1[r+3]);}
  const float m=max2f(a,b);
  auto rr=__builtin_amdgcn_permlane32_swap(__float_as_uint(m),__float_as_uint(m),false,false);
  return max2f(__uint_as_float(rr[0]),__uint_as_float(rr[1]));
}
__device__ __forceinline__ void pv(f32x16*o,int vb,bf16x8 pa0,bf16x8 pa1,bf16x8 pa2,bf16x8 pa3){
  #pragma unroll
  for(int d0=0;d0<2;++d0){s16x4 lo[4],hi[4];
    #pragma unroll
    for(int ks=0;ks<4;++ks){
      asm volatile("ds_read_b64_tr_b16 %0,%1 offset:%c2":"=&v"(lo[ks]):"v"(vb),"i"(d0*4096+ks*1024):"memory");
      asm volatile("ds_read_b64_tr_b16 %0,%1 offset:%c2":"=&v"(hi[ks]):"v"(vb),"i"(d0*4096+ks*1024+512):"memory");}
    asm volatile("s_waitcnt lgkmcnt(0)":::"memory");SBAR();
    #define PK(k) (bf16x8){lo[k][0],lo[k][1],lo[k][2],lo[k][3],hi[k][0],hi[k][1],hi[k][2],hi[k][3]}
    o[d0]=__builtin_amdgcn_mfma_f32_32x32x16_bf16(pa0,PK(0),o[d0],0,0,0);
    o[d0]=__builtin_amdgcn_mfma_f32_32x32x16_bf16(pa1,PK(1),o[d0],0,0,0);
    o[d0]=__builtin_amdgcn_mfma_f32_32x32x16_bf16(pa2,PK(2),o[d0],0,0,0);
    o[d0]=__builtin_amdgcn_mfma_f32_32x32x16_bf16(pa3,PK(3),o[d0],0,0,0);
    #undef PK
  }
}

#ifndef ATTN_STORE16
#define ATTN_STORE16(p,v) (*(u32x4*)(p)=(v))
#endif
template<int THRL,bool FIX> __device__ __forceinline__ void attn_unit(float mfix,int b,int h,int qb,const bf16*Q,const bf16*__restrict__ K,const bf16*__restrict__ V,const bf16*__restrict__ Z,bf16*O,char*shm){
  const int tid=threadIdx.x,lane=tid&63,r32=lane&31,hi=lane>>5; const int wid=__builtin_amdgcn_readfirstlane(tid>>6);
  const long rowbase=(long)b*SEQ; const int q0=qb*QB;
  const bf16*Qw=Q+(rowbase+q0+wid*QBLK)*QP+h*D;
  const long kvbase=(long)b*SKV*KP+(h>>2)*D; const bf16*Kh=K+kvbase,*Vh=V+kvbase;
  const unsigned lds0=(unsigned)(uintptr_t)shm;
  float*wsf=(float*)(shm+LDS_WS)+wid*64;
  const bf16*ksrc=Kh+(long)lane*KP+wid*8;
  const bf16*vsrc=Vh+(long)(16*(wid&3)+(lane>>2))*KP+(wid>>2)*32+(lane&3)*8;
  const unsigned kdst=lds0+LDS_K+wid*1024, vdst=lds0+LDS_V+wid*1024;
  #define DMA_K(t,slot) glds16(ksrc+(long)(t)*KVBLK*KP,(unsigned)__builtin_amdgcn_readfirstlane(kdst+(slot)))
  #define DMA_V(t,slot) glds16(vsrc+(long)(t)*KVBLK*KP,(unsigned)__builtin_amdgcn_readfirstlane(vdst+(slot)))
  const int vb0=(int)(lds0+LDS_V)+((lane>>4)&1)*32+(lane&3)*8+(4*hi+((lane&15)>>2))*64;
  const char*Kbase=shm+LDS_K; bf16x8 kf[8];
  const lds_cptr shm3=(lds_cptr)shm; const lds_cptr kp0=shm3+LDS_K+hi*1024+r32*16; const lds_cptr vp0=shm3+LDS_V+((lane>>4)&1)*32+(lane&3)*8+(4*hi+((lane&15)>>2))*64;
  constexpr int NT=SKV/KVBLK;
  DMA_K(0,0);DMA_V(0,0);DMA_K(1,SLOTB);
  bf16x8 qr[4];
  #pragma unroll
  for(int d0=0;d0<4;++d0)qr[d0]=*reinterpret_cast<const bf16x8*>(&Qw[(long)r32*QP+d0*16+hi*8]);
  float mhat=0.f,l_reg=0.f;f32x16 o[2];o[0]=f32x16{};o[1]=f32x16{};f32x16 negm=f32x16{};
  if constexpr(FIX){ mhat=mfix; _Pragma("unroll") for(int r=0;r<16;++r)negm[r]=-mfix; }
  asm volatile("":"+v"(negm));
  const int qrel=wid*QBLK+r32;
  #define CMASK(P0,P1,t) do{}while(0)
  bool resc=false;
  #define START(P0,P1) do{ resc=false; \
    if constexpr(!FIX){ const float rm=rowmax(P0,P1); const float dl=rm; mhat=fadd_s(mhat,dl); \
      _Pragma("unroll") for(int r=0;r<16;++r){P0[r]=fsub_s(P0[r],dl);P1[r]=fsub_s(P1[r],dl);} \
      _Pragma("unroll") for(int r=0;r<16;++r)negm[r]=-mhat; asm volatile("":"+v"(negm)); } \
    _Pragma("unroll") for(int r=0;r<16;++r)P0[r]=__builtin_amdgcn_exp2f(P0[r]); }while(0)
  #define RESC() do{ if(resc){ asm volatile("s_waitcnt lgkmcnt(0)":::"memory"); \
      _Pragma("unroll") for(int d_=0;d_<2;++d_) _Pragma("unroll") for(int r=0;r<16;++r)o[d_][r]*=wsf[crow(r,hi)]; } }while(0)
  f32x16 pA0,pA1,pB0,pB1;
  int sl_prev=0,sl_cur=0,sl_next=SLOTB;
  #define ROT() do{sl_prev=sl_cur;sl_cur=sl_next;sl_next=(sl_next==(NSLOT-1)*SLOTB)?0:sl_next+SLOTB;}while(0)
  DMA_K(2,2*SLOTB);
  WAIT_BAR(3);
  qkt(pA0,pA1,Kbase,qr,negm,r32,hi);asm volatile("s_nop 15\n\ts_nop 7":"+v"(pA0),"+v"(pA1));CMASK(pA0,pA1,0);
  START(pA0,pA1);
  _Pragma("unroll") for(int r=0;r<16;++r)pA1[r]=__builtin_amdgcn_exp2f(pA1[r]);
  WAIT_BAR(0);
  DMA_K(3,0);DMA_V(1,SLOTB);
  ROT();
  kload8(kf,kp0+sl_cur);
  WAIT_BAR(2);
  s16x4 vlo[8],vhi[8]; u32x4 pw0,pw1,pw2,pw3;
  #define PKW(P,B) cvtpk_s(P[B],P[B+1])
  #define PAF(k) __builtin_bit_cast(bf16x8,pw##k)
  #define VFR(i) (bf16x8){vlo[i][0],vlo[i][1],vlo[i][2],vlo[i][3],vhi[i][0],vhi[i][1],vhi[i][2],vhi[i][3]}
  #define PIN(x) asm volatile("":"+v"(x))
  #define MX3(a,b,c) __builtin_fmaxf(__builtin_fmaxf((a),(b)),(c))
  #define GAPA(MF,A0,A1,A2,A3,W0,W1,PW) do{ MF; sacc+=A0; sacc+=A1; sacc+=A2; sacc+=A3; PIN(sacc); W0; W1; PIN(PW); SBAR(); }while(0)
  #define EX(v) __builtin_amdgcn_exp2f(v)
  #define GAPB(MF,X,B) do{ MF; X[B]=EX(X[B]); X[B+1]=EX(X[B+1]); X[B+2]=EX(X[B+2]); X[B+3]=EX(X[B+3]); PIN(X); SBAR(); }while(0)
  #define VRD(i) do{ vlo[i]=vtr(vp_+(((i)>>2)*4096+((i)&3)*1024)); vhi[i]=vtr(vp_+(((i)>>2)*4096+((i)&3)*1024+512)); }while(0)
  #define KRD(G,j) do{ if(G){ kload2(kf,kp0+sl_next,j); SBAR(); } }while(0)
  #define STEP(C0,C1,P0,P1,t,GK,GV,GL) do{ SBAR(); \
    const lds_cptr vp_=vp0+sl_prev; \
    VRD(0); SBAR(); float sacc=(P0[0]+P0[1]); \
    GAPA(C0=__builtin_amdgcn_mfma_f32_32x32x16_bf16(kf[0],qr[0],negm,0,0,0), P0[2],P0[3],P0[4],P0[5],     pw0[0]=PKW(P0,0), pw0[1]=PKW(P0,2), pw0); \
    VRD(4); SBAR(); GAPA(C1=__builtin_amdgcn_mfma_f32_32x32x16_bf16(kf[1],qr[0],negm,0,0,0), P0[6],P0[7],P0[8],P0[9],     pw0[2]=PKW(P0,4), pw0[3]=PKW(P0,6), pw0); \
    VRD(1); SBAR(); GAPA(C0=__builtin_amdgcn_mfma_f32_32x32x16_bf16(kf[2],qr[1],C0,0,0,0),   P0[10],P0[11],P0[12],P0[13], pw1[0]=PKW(P0,8), pw1[1]=PKW(P0,10), pw1); \
    VRD(5); SBAR(); GAPA(C1=__builtin_amdgcn_mfma_f32_32x32x16_bf16(kf[3],qr[1],C1,0,0,0),   P0[14],P0[15],P1[0],P1[1],   pw1[2]=PKW(P0,12),pw1[3]=PKW(P0,14), pw1); \
    VRD(2); SBAR(); GAPA(C0=__builtin_amdgcn_mfma_f32_32x32x16_bf16(kf[4],qr[2],C0,0,0,0),   P1[2],P1[3],P1[4],P1[5],     pw2[0]=PKW(P1,0), pw2[1]=PKW(P1,2), pw2); \
    VRD(6); SBAR(); GAPA(C1=__builtin_amdgcn_mfma_f32_32x32x16_bf16(kf[5],qr[2],C1,0,0,0),   P1[6],P1[7],P1[8],P1[9],     pw2[2]=PKW(P1,4), pw2[3]=PKW(P1,6), pw2); \
    VRD(3); SBAR(); GAPA(C0=__builtin_amdgcn_mfma_f32_32x32x16_bf16(kf[6],qr[3],C0,0,0,0),   P1[10],P1[11],P1[12],P1[13], pw3[0]=PKW(P1,8), pw3[1]=PKW(P1,10), pw3); \
    VRD(7); SBAR(); GAPA(C1=__builtin_amdgcn_mfma_f32_32x32x16_bf16(kf[7],qr[3],C1,0,0,0),   P1[14],P1[15],0.f,0.f,       pw3[2]=PKW(P1,12),pw3[3]=PKW(P1,14), pw3); \
    l_reg+=sacc; \
    if(GK){DMA_K((t)+3,sl_cur);} if(GV){DMA_V((t)+1,sl_next);} \
    CMASK(C0,C1,t); \
    if constexpr(!FIX){ float a=MX3(C0[0],C0[1],C1[0]),b=MX3(C0[2],C0[3],C1[1]); a=MX3(a,C1[2],C1[3]); \
      _Pragma("unroll") for(int r=4;r<16;r+=4){a=MX3(a,C0[r],C0[r+1]);b=MX3(b,C0[r+2],C0[r+3]);a=MX3(a,C1[r],C1[r+1]);b=MX3(b,C1[r+2],C1[r+3]);} \
      float rm=__builtin_fmaxf(a,b); { auto rr=__builtin_amdgcn_permlane32_swap(__float_as_uint(rm),__float_as_uint(rm),false,false); rm=__builtin_fmaxf(__uint_as_float(rr[0]),__uint_as_float(rr[1])); } \
      resc=false; \
      if(__builtin_expect(__any(rm>(float)THRL),0)){ const float dl=__builtin_fmaxf(rm,0.f); mhat+=dl; \
        _Pragma("unroll") for(int r=0;r<16;++r){C0[r]-=dl;C1[r]-=dl;} \
        _Pragma("unroll") for(int r=0;r<16;++r)negm[r]=-mhat; asm volatile("":"+v"(negm)); \
        const float f=__builtin_amdgcn_exp2f(-dl); l_reg*=f; if(hi==0)wsf[r32]=f; resc=true; } } \
    SBAR(); \
    GAPB(o[0]=__builtin_amdgcn_mfma_f32_32x32x16_bf16(PAF(0),VFR(0),o[0],0,0,0), C0,0); \
    GAPB(o[1]=__builtin_amdgcn_mfma_f32_32x32x16_bf16(PAF(0),VFR(4),o[1],0,0,0), C0,4); \
    KRD(GL,0); GAPB(o[0]=__builtin_amdgcn_mfma_f32_32x32x16_bf16(PAF(1),VFR(1),o[0],0,0,0), C0,8); \
    KRD(GL,1); GAPB(o[1]=__builtin_amdgcn_mfma_f32_32x32x16_bf16(PAF(1),VFR(5),o[1],0,0,0), C0,12); \
    KRD(GL,2); GAPB(o[0]=__builtin_amdgcn_mfma_f32_32x32x16_bf16(PAF(2),VFR(2),o[0],0,0,0), C1,0); \
    KRD(GL,3); GAPB(o[1]=__builtin_amdgcn_mfma_f32_32x32x16_bf16(PAF(2),VFR(6),o[1],0,0,0), C1,4); \
    GAPB(o[0]=__builtin_amdgcn_mfma_f32_32x32x16_bf16(PAF(3),VFR(3),o[0],0,0,0), C1,8); \
    GAPB(o[1]=__builtin_amdgcn_mfma_f32_32x32x16_bf16(PAF(3),VFR(7),o[1],0,0,0), C1,12); \
    }while(0)
  int t=1;
  #undef CMASK
  #define CMASK(P0,P1,t) do{}while(0)
  for(;t+5<NT;t+=2){
    STEP(pB0,pB1,pA0,pA1,t,true,true,true);     WAIT_BAR(2); RESC(); ROT();
    STEP(pA0,pA1,pB0,pB1,t+1,true,true,true);   WAIT_BAR(2); RESC(); ROT();
  }
  #undef CMASK
  #define CMASK(P0,P1,t) do{}while(0)
  #define ENDW(tt) do{ if((tt)+3<NT){WAIT_BAR(2);} else if((tt)+2<NT){WAIT_BAR(1);} else {WAIT_BAR(0);} }while(0)
  for(;t+1<NT;t+=2){
    STEP(pB0,pB1,pA0,pA1,t,(t+3<NT),(t+1<NT),(t+1<NT));       ENDW(t);   RESC(); ROT();
    STEP(pA0,pA1,pB0,pB1,t+1,(t+4<NT),(t+2<NT),(t+2<NT));     ENDW(t+1); RESC(); ROT();
  }
  STEP(pB0,pB1,pA0,pA1,NT-1,false,false,false); RESC();
  { float sacc=pB0[0]+pB0[1]; _Pragma("unroll") for(int r=2;r<16;++r)sacc+=pB0[r]; _Pragma("unroll") for(int r=0;r<16;++r)sacc+=pB1[r]; l_reg+=sacc;
    pw0=(u32x4){PKW(pB0,0),PKW(pB0,2),PKW(pB0,4),PKW(pB0,6)};pw1=(u32x4){PKW(pB0,8),PKW(pB0,10),PKW(pB0,12),PKW(pB0,14)};pw2=(u32x4){PKW(pB1,0),PKW(pB1,2),PKW(pB1,4),PKW(pB1,6)};pw3=(u32x4){PKW(pB1,8),PKW(pB1,10),PKW(pB1,12),PKW(pB1,14)};
    SBAR(); pv(o,vb0+sl_cur,PAF(0),PAF(1),PAF(2),PAF(3)); }
  #undef PKW
  #undef PAF
  #undef VFR
  #undef PIN
  #undef MX3
  #undef GAPA
  #undef GAPB
  #undef EX
  #undef VRD
  #undef KRD
  #undef STEP
  #undef ENDW
  {auto rr=__builtin_amdgcn_permlane32_swap(__float_as_uint(l_reg),__float_as_uint(l_reg),false,false);l_reg=__uint_as_float(rr[0])+__uint_as_float(rr[1]);}
  if(hi==0)wsf[32+r32]=l_reg;asm volatile("s_waitcnt lgkmcnt(0)":::"memory");
  float rli[16];
  #pragma unroll
  for(int r=0;r<16;++r)rli[r]=__builtin_amdgcn_rcpf(wsf[32+crow(r,hi)]);
  const long orow0=(rowbase+q0+wid*QBLK)*OP+h*D; bf16*Ow=O+orow0; const bf16*Zw=Z+orow0;
  { bf16*stg=(bf16*)(shm+LDS_OST)+wid*2048;
    #pragma unroll
    for(int r=0;r<16;++r){const int orow=crow(r,hi);
      #pragma unroll
      for(int d0=0;d0<2;++d0)stg[orow*64+d0*32+r32]=__float2bfloat16(o[d0][r]*rli[r]);}
    asm volatile("s_waitcnt lgkmcnt(0)":::"memory");
    #pragma unroll
    for(int i=0;i<4;++i){const int row=i*8+(lane>>3),ch=lane&7; const u32x4 v=*(const u32x4*)(stg+row*64+ch*8); const u32x4 z=*(const u32x4*)(Zw+(long)row*OP+ch*8);
      u32x4 w; w.x=cvtpk_s(__uint_as_float(v.x<<16)*__uint_as_float(z.x<<16),__uint_as_float(v.x&0xffff0000u)*__uint_as_float(z.x&0xffff0000u));
      w.y=cvtpk_s(__uint_as_float(v.y<<16)*__uint_as_float(z.y<<16),__uint_as_float(v.y&0xffff0000u)*__uint_as_float(z.y&0xffff0000u));
      w.z=cvtpk_s(__uint_as_float(v.z<<16)*__uint_as_float(z.z<<16),__uint_as_float(v.z&0xffff0000u)*__uint_as_float(z.z&0xffff0000u));
      w.w=cvtpk_s(__uint_as_float(v.w<<16)*__uint_as_float(z.w<<16),__uint_as_float(v.w&0xffff0000u)*__uint_as_float(z.w&0xffff0000u));
      ATTN_STORE16(Ow+(long)row*OP+ch*8,w);} }
  asm volatile("s_waitcnt lgkmcnt(0)\n\ts_barrier":::"memory");
  #undef DMA_K
  #undef DMA_V
  #undef CMASK
  #undef START
  #undef RESC
  #undef ROT
}
constexpr int ATTN_LDS_BYTES=LDS_BYTES;
struct AttnTensors { const bf16* Q; const bf16* K; const bf16* V; const bf16* Z; bf16* O; };
template<int THRL,bool FIX> __device__ __forceinline__ void attn_phase(char*lds,const AttnTensors&T,int vcu,int G,float mfix){
  for(int u=vcu;u<1024;u+=G){ const int un=(G==256)?((vcu<<2)+((u-vcu)>>8)):u;
    attn_unit<THRL,FIX>(mfix,un>>6,(un>>3)&7,un&7,T.Q,T.K,T.V,T.Z,T.O,lds); }
}
#undef SBAR
#undef WAIT_BAR
}
constexpr int NWAVES = 8;
constexpr int BATCH = 16, SEQ = 2048, DM = 1024, CTX = 256, DIN = 2816, DCONV = 512;
constexpr int M = BATCH * SEQ;
constexpr int MC = BATCH * CTX;
constexpr size_t MiB = 1u << 20;
constexpr size_t WS_MOD = 0, WS_ROPE = 1 * MiB, WS_WIN = 2 * MiB, WS_WPW = 8 * MiB, WS_WOUT = 9 * MiB, WS_CTL = 12 * MiB, WS_U = 16 * MiB, WS_UG = 88 * MiB, WS_Y = WS_U, WS_MIX = WS_U + 40 * MiB,
                 WS_Q = 120 * MiB, WS_KA = 152 * MiB, WS_VA = 162 * MiB, WS_Z = 172 * MiB, WS_END = 236 * MiB;
static_assert(WS_U + 72 * MiB == WS_UG && WS_MIX + 64 * MiB == WS_UG + 32 * MiB && WS_UG + 32 * MiB <= WS_Q, "overlay map");
constexpr size_t CTL_ZERO_BYTES = 16384;
constexpr int RING_BYTES = 131072, MISC_OFF = RING_BYTES + 320, LDS_BYTES = 147456;
#define LAS __attribute__((address_space(3)))
typedef unsigned short bf16;
typedef unsigned v4u __attribute__((ext_vector_type(4)));
typedef float f32x4 __attribute__((ext_vector_type(4)));
typedef float f32x2 __attribute__((ext_vector_type(2)));
#define LDS_WAIT() asm volatile("s_waitcnt lgkmcnt(0)" ::: "memory")
__device__ __forceinline__ unsigned pk2(float lo, float hi) { return pg8::cvt_pk_bf16(lo, hi); }
__device__ __forceinline__ float wave_sum(float v) {
#pragma unroll
    for (int o = 1; o < 64; o <<= 1) v += __shfl_xor(v, o);
    return v;
}
#define GAS __attribute__((address_space(1)))
#define RLX_AGENT __ATOMIC_RELAXED, __HIP_MEMORY_SCOPE_AGENT
#define XB_TMO      128
#define XB_XCNT(j)  (256  + 64 * (j))
#define XB_XSUB(j)  (1280 + 64 * (j))
#define XB_XGEN(j)  (2304 + 64 * (j))
#define XB_TOP      3328
#define XB_TOPGEN   3392
#define XCD_BAR_WORDS 3456
#define XB_SPIN_CAP (1u << 18)

__device__ __forceinline__ unsigned xb_ld(unsigned* p)              { return __hip_atomic_load(p, __ATOMIC_RELAXED, __HIP_MEMORY_SCOPE_AGENT); }
__device__ __forceinline__ unsigned xb_add(unsigned* p, unsigned v) { return __hip_atomic_fetch_add(p, v, __ATOMIC_RELAXED, __HIP_MEMORY_SCOPE_AGENT); }
__device__ __forceinline__ unsigned xb_xcc_id() { return (unsigned)__builtin_amdgcn_s_getreg((3 << 11) | 20) & 0xFu; }
#define XB_SPIN(cond, bar) do { unsigned _sp = 0; while (cond) { __builtin_amdgcn_s_sleep(1); \
    if ((++_sp & 255u) == 0u) { if (xb_ld(&(bar)[XB_TMO])) break; if (_sp > XB_SPIN_CAP) { atomicAdd(&(bar)[XB_TMO], 1u); break; } } } } while (0)

struct XcdBarrier {
    unsigned* bar; unsigned x;
    volatile LAS unsigned* st;
};

__device__ __forceinline__ XcdBarrier xcd_barrier_post(unsigned* bar, volatile LAS unsigned* st) {
    XcdBarrier b; b.bar = bar; b.x = xb_xcc_id(); b.st = st;
    if (threadIdx.x == 0) (void)xb_add(&bar[XB_XCNT(b.x)], 1u);
    return b;
}
__device__ __forceinline__ void xcd_barrier_complete(unsigned* bar, unsigned x, unsigned& nloc, unsigned& nx) {
    const unsigned G = gridDim.x * gridDim.y * gridDim.z;
    unsigned sum, cnt, mine, sp = 0u;
    for (;;) {
        sum = 0u; cnt = 0u; mine = 0u;
#pragma unroll
        for (unsigned j = 0; j < 16; ++j) { const unsigned c = xb_ld(&bar[XB_XCNT(j)]); sum += c; cnt += (c > 0u) ? 1u : 0u; mine = (j == x) ? c : mine; }
        if (sum == G) break;
        __builtin_amdgcn_s_sleep(1);
        if ((++sp & 255u) == 0u) { if (xb_ld(&bar[XB_TMO])) break; if (sp > XB_SPIN_CAP) { atomicAdd(&bar[XB_TMO], 1u); break; } }
    }
    nloc = mine > 0u ? mine : 1u; nx = cnt > 0u ? cnt : 1u;
}

__device__ __forceinline__ void xcd_barrier(const XcdBarrier& b) {
    asm volatile("s_waitcnt vmcnt(0)" ::: "memory");
    __syncthreads();
    if (threadIdx.x == 0) {
        unsigned* bar = b.bar;
        __builtin_amdgcn_s_waitcnt(0);
        unsigned nloc = b.st[0], nx = b.st[1];
        if (nloc == 0u) { xcd_barrier_complete(bar, b.x, nloc, nx); b.st[0] = nloc; b.st[1] = nx; }
        const unsigned old = xb_add(&bar[XB_XSUB(b.x)], 1u);
        const unsigned gen = old / nloc;
        if (old + 1u == (gen + 1u) * nloc) {
            __builtin_amdgcn_fence(__ATOMIC_RELEASE, "agent");
            asm volatile("s_waitcnt vmcnt(0)" ::: "memory");
            const unsigned og = xb_add(&bar[XB_TOP], 1u);
            const unsigned tg = og / nx;
            if (og + 1u == (tg + 1u) * nx) xb_add(&bar[XB_TOPGEN], 1u);
            else XB_SPIN(xb_ld(&bar[XB_TOPGEN]) == tg, bar);
            __builtin_amdgcn_fence(__ATOMIC_ACQUIRE, "agent");
            xb_add(&bar[XB_XGEN(b.x)], 1u);
            asm volatile("s_waitcnt vmcnt(0)" ::: "memory");
        } else {
            XB_SPIN(xb_ld(&bar[XB_XGEN(b.x)]) == gen, bar);
            __builtin_amdgcn_fence(__ATOMIC_ACQUIRE, "agent");
            asm volatile("s_waitcnt vmcnt(0)" ::: "memory");
        }
    }
    __syncthreads();
}
__device__ __forceinline__ int lmap_in(int P) {
    if (P < 768) { const int tile = P >> 8, p = P & 255, bj = p >> 7, wc = (p >> 5) & 3, j = p & 31; return tile * 256 + wc * 64 + ((j < 16) ? j : j + 16) + 16 * bj; }
    if (P >= 1280 && P < 2304) { const int q = P - 1280, T = q >> 8, p = q & 255; return (p < 128) ? (1280 + 128 * T + p) : (1792 + 128 * T + (p - 128)); }
    return P;
}
template <bool MAP> __device__ __forceinline__ void p0_transpose_item(const float* W, int K, int N, bf16* WT, LAS float* scr, int item, int lane) {
    const int nblk = N / 32, kb = item / nblk, nb = item % nblk, k0 = 64 * kb, n0 = 32 * nb;
    const int ncol = MAP ? lmap_in(n0 + (lane & 31)) : (n0 + (lane & 31));
#pragma unroll 8
    for (int i = 0; i < 32; ++i) { const int kk = 2 * i + (lane >> 5); scr[kk * 33 + (lane & 31)] = __builtin_nontemporal_load(W + (size_t)(k0 + kk) * N + ncol); }
    LDS_WAIT(); asm volatile("" ::: "memory");
    const int c = lane & 7;
#pragma unroll
    for (int j = 0; j < 4; ++j) { const int n = (lane >> 3) + 8 * j; const LAS float* s = scr + (8 * c) * 33 + n;
        v4u o; o.x = pk2(s[0 * 33], s[1 * 33]); o.y = pk2(s[2 * 33], s[3 * 33]); o.z = pk2(s[4 * 33], s[5 * 33]); o.w = pk2(s[6 * 33], s[7 * 33]);
        *(v4u*)(WT + (size_t)(n0 + n) * K + k0 + 8 * c) = o; }
    LDS_WAIT(); asm volatile("" ::: "memory");
}
__device__ __forceinline__ void mod_item(LAS unsigned char* lds, const float* c, const float* cctx, const float* wmod, const float* bmod, float* MOD, int nc, int tid) {
    LAS float* sc = (LAS float*)lds;
    LAS float* part = sc + 17 * 1024;
    const int w = tid >> 6, lane = tid & 63, col = lane & 15, kq = lane >> 4, n = nc * 16 + col, kbase = 128 * w + 32 * kq;
    float wv[32];
#pragma unroll
    for (int i = 0; i < 32; ++i) wv[i] = __builtin_nontemporal_load(wmod + (size_t)(kbase + i) * 3072 + n);
    for (int idx = tid; idx < 17 * 1024; idx += 512) { const int r = idx >> 10, k = idx & 1023; const float v = (r < 16) ? c[r * 1024 + k] : cctx[k]; sc[idx] = pg8::silu_f(v); }
    __syncthreads();
    float acc[17];
#pragma unroll
    for (int r = 0; r < 17; ++r) acc[r] = 0.f;
#pragma unroll
    for (int i = 0; i < 32; ++i) {
#pragma unroll
        for (int r = 0; r < 17; ++r) acc[r] += sc[r * 1024 + kbase + i] * wv[i]; }
#pragma unroll
    for (int r = 0; r < 17; ++r) part[((w * 4 + kq) * 17 + r) * 16 + col] = acc[r];
    __syncthreads();
    for (int idx = tid; idx < 17 * 16; idx += 512) { const int r = idx >> 4, l = idx & 15; float sum = bmod[nc * 16 + l];
#pragma unroll
        for (int p = 0; p < 32; ++p) sum += part[(p * 17 + r) * 16 + l];
        MOD[(size_t)r * 3072 + nc * 16 + l] = sum; }
    __syncthreads();
}
__device__ __forceinline__ void p1_rows(const float* x, const float* ctx, const float* normw, const float* MOD, bf16* U, int gw, int NGW, int lane) {
    for (int ch = gw; ch < (M + MC) / 4; ch += NGW) {
        const int row0 = 4 * ch; const bool isc = row0 >= M; const int b = isc ? 16 : (row0 >> 11);
        const float* src = isc ? ctx + (size_t)(row0 - M) * DM : x + (size_t)row0 * DM;
        const float* mp = MOD + (size_t)b * 3072;
        f32x4 g[4], sh[4];
#pragma unroll
        for (int j = 0; j < 4; ++j) { const int col = 4 * lane + 256 * j; const f32x4 nw = *(const f32x4*)(normw + col), scl = *(const f32x4*)(mp + 1024 + col); sh[j] = *(const f32x4*)(mp + col); g[j] = nw * (1.0f + scl); }
        f32x4 vv[4][4];
#pragma unroll
        for (int rr = 0; rr < 4; ++rr) { const f32x4* xr = (const f32x4*)(src + (size_t)rr * DM) + lane;
#pragma unroll
            for (int j = 0; j < 4; ++j) vv[rr][j] = __builtin_nontemporal_load(xr + 64 * j); }
        asm volatile("" ::: "memory");
#pragma unroll
        for (int rr = 0; rr < 4; ++rr) {
            f32x4 v[4]; float s = 0.f;
#pragma unroll
            for (int j = 0; j < 4; ++j) { v[j] = vv[rr][j]; s += (v[j].x * v[j].x + v[j].y * v[j].y) + (v[j].z * v[j].z + v[j].w * v[j].w); }
            const float rinv = rsqrtf(wave_sum(s) * (1.0f / DM) + 1e-6f);
            unsigned long long* o8 = (unsigned long long*)(U + (size_t)(row0 + rr) * DM) + lane;
#pragma unroll
            for (int j = 0; j < 4; ++j) { const f32x4 o = v[j] * rinv * g[j] + sh[j];
                o8[64 * j] = (unsigned long long)pk2(o.x, o.y) | ((unsigned long long)pk2(o.z, o.w) << 32); }
        }
    }
}
__device__ __forceinline__ void conv_phase(LAS unsigned char* lds, const bf16* UG, const float* cw, const float* cb, const float* lnw, const float* lnb, bf16* Y, int vcu, int G, int tid) {
    LAS float* tile = (LAS float*)lds;
    const int cp = tid & 255, th = tid >> 8, wv = tid >> 6, lane = tid & 63;
    f32x2 w[31];
#pragma unroll
    for (int j = 0; j < 31; ++j) w[j] = *(const f32x2*)(cw + j * 512 + 2 * cp);
    const f32x2 bias = *(const f32x2*)(cb + 2 * cp);
    for (int item = vcu; item < M / 32; item += G) {
        const int row0 = item * 32 + th * 16, t0 = row0 & 2047;
        const unsigned* ub = (const unsigned*)(UG + (size_t)(row0 - t0) * 512 + 2 * cp);
        unsigned xr[46];
#pragma unroll
        for (int r = 0; r < 46; ++r) { const int tin = t0 - 15 + r, tc = tin < 0 ? 0 : (tin > 2047 ? 2047 : tin); xr[r] = ub[(size_t)tc * 256]; }
        f32x2 acc[16];
#pragma unroll
        for (int i = 0; i < 16; ++i) acc[i] = (f32x2){0.f, 0.f};
#pragma unroll
        for (int r = 0; r < 46; ++r) {
            const int tin = t0 - 15 + r; const bool ok = (tin >= 0) && (tin < 2048);
            const f32x2 xv = (f32x2){ok ? pg8::bf_lo(xr[r]) : 0.f, ok ? pg8::bf_hi(xr[r]) : 0.f};
#pragma unroll
            for (int i = 0; i < 16; ++i) { const int j = r - i; if (j >= 0 && j <= 30) acc[i] += xv * w[j]; }
        }
#pragma unroll
        for (int i = 0; i < 16; ++i) *(LAS f32x2*)(tile + (th * 16 + i) * 512 + 2 * cp) = acc[i] + bias;
        __syncthreads();
        const f32x4 lw0 = *(const f32x4*)(lnw + 8 * lane), lw1 = *(const f32x4*)(lnw + 8 * lane + 4), lb0 = *(const f32x4*)(lnb + 8 * lane), lb1 = *(const f32x4*)(lnb + 8 * lane + 4);
#pragma unroll
        for (int rr = 0; rr < 4; ++rr) {
            const int row = 4 * wv + rr;
            const f32x4 a = *(const LAS f32x4*)(tile + row * 512 + 8 * lane), b = *(const LAS f32x4*)(tile + row * 512 + 8 * lane + 4);
            const float mean = wave_sum((a.x + a.y) + (a.z + a.w) + (b.x + b.y) + (b.z + b.w)) * (1.0f / 512.0f);
            const f32x4 da = a - mean, db = b - mean;
            const float var = wave_sum((da.x * da.x + da.y * da.y) + (da.z * da.z + da.w * da.w) + (db.x * db.x + db.y * db.y) + (db.z * db.z + db.w * db.w)) * (1.0f / 512.0f);
            const float rstd = rsqrtf(var + 1e-6f);
            const f32x4 ya = da * rstd * lw0 + lb0, yb = db * rstd * lw1 + lb1;
            v4u o; o.x = pk2(pg8::silu_f(ya.x), pg8::silu_f(ya.y)); o.y = pk2(pg8::silu_f(ya.z), pg8::silu_f(ya.w)); o.z = pk2(pg8::silu_f(yb.x), pg8::silu_f(yb.y)); o.w = pk2(pg8::silu_f(yb.z), pg8::silu_f(yb.w));
            *(v4u*)(Y + (size_t)(item * 32 + row) * 512 + 8 * lane) = o;
        }
        __syncthreads();
    }
}

#ifndef MK_N_LAUNCHES
#define MK_N_LAUNCHES 1
#endif
constexpr int N_PHASES = 6;
struct Args { const float* in[17]; float* out; unsigned char* ws; int ph_lo, ph_hi; };
__global__ void __launch_bounds__(NWAVES * 64, 2) hybrid_fwd(Args args) {
    extern __shared__ __attribute__((aligned(16))) unsigned char lds[];
    LAS unsigned char* ldsl = (LAS unsigned char*)lds;
    const int tid = threadIdx.x, lane = tid & 63, wave = __builtin_amdgcn_readfirstlane(tid >> 6);
    const int G = gridDim.x, bx = blockIdx.x, vcu = (G % 8 == 0) ? (bx % 8) * (G / 8) + bx / 8 : bx;
    const int gw = vcu * NWAVES + wave, NGW = G * NWAVES;
    unsigned char* ws = args.ws;
    const float *x = args.in[0], *cvec = args.in[1], *ctx = args.in[2], *cctx = args.in[3], *wmod = args.in[4], *bmod = args.in[5], *normw = args.in[6], *win = args.in[7],
                *qnw = args.in[8], *knw = args.in[9], *convw = args.in[10], *convb = args.in[11], *lnw = args.in[12], *lnb = args.in[13], *wpw = args.in[14], *bpw = args.in[15], *wout = args.in[16];
    float* MOD = (float*)(ws + WS_MOD); float* ROPE = (float*)(ws + WS_ROPE);
    bf16 *WIN_T = (bf16*)(ws + WS_WIN), *WPW_T = (bf16*)(ws + WS_WPW), *WOUT_T = (bf16*)(ws + WS_WOUT), *U = (bf16*)(ws + WS_U), *Q = (bf16*)(ws + WS_Q), *KA = (bf16*)(ws + WS_KA), *VA = (bf16*)(ws + WS_VA),
         *Z = (bf16*)(ws + WS_Z), *UG = (bf16*)(ws + WS_UG), *Y = (bf16*)(ws + WS_Y), *MIX = (bf16*)(ws + WS_MIX);
    const int lo = args.ph_lo, hi = args.ph_hi;
#define IN(k) (lo <= (k) && (k) < hi)
    for (int u = tid; u < (LDS_BYTES - RING_BYTES) / 4; u += NWAVES * 64) ((LAS unsigned*)(ldsl + RING_BYTES))[u] = 0u;
    __syncthreads();
    XcdBarrier bar; bar.bar = (unsigned*)(ws + WS_CTL); bar.x = 0; bar.st = nullptr;
    if (hi - lo > 1) bar = xcd_barrier_post((unsigned*)(ws + WS_CTL), (volatile LAS unsigned*)(ldsl + MISC_OFF) + 8);
    if (lo > 99) cooperative_groups::this_grid().sync();
#define SEAM(k) do { if (IN(k) && IN((k) + 1)) xcd_barrier(bar); } while (0)
#ifndef REPMASK
#define REPMASK 0
#endif
#define REPS(k) for (int rep_ = 0; rep_ < 1 + ((REPMASK >> (k)) & 1); ++rep_)

    if (IN(0)) REPS(0) {
        LAS float* scr = (LAS float*)(ldsl + wave * 16384);
        constexpr int I_IN = (DM / 64) * (DIN / 32), I_PW = (DCONV / 64) * (DCONV / 32), I_OUT = (DM / 64) * (DM / 32);
        for (int it = gw; it < I_IN + I_PW + I_OUT; it += NGW) {
            int r = it;
            if (r < I_IN) { p0_transpose_item<true>(win, DM, DIN, WIN_T, scr, r, lane); continue; } r -= I_IN;
            if (r < I_PW) { p0_transpose_item<false>(wpw, DCONV, DCONV, WPW_T, scr, r, lane); continue; } r -= I_PW;
            p0_transpose_item<false>(wout, DM, DM, WOUT_T, scr, r, lane);
        }
        { const int gt = bx * 512 + tid;
          if (gt < 1024) { const int pos = gt >> 4, f = gt & 15; const float freq = powf(10000.0f, -(float)f * (1.0f / 16.0f)); const float ang = (float)pos * freq;
              ROPE[2 * gt] = cosf(ang); ROPE[2 * gt + 1] = sinf(ang); } }
        __syncthreads();
        for (int nc = bx; nc < 192; nc += G) mod_item(ldsl, cvec, cctx, wmod, bmod, MOD, nc, tid);
    }
    SEAM(0);
    if (IN(1)) REPS(1) p1_rows(x, ctx, normw, MOD, U, gw, NGW, lane);
    SEAM(1);
    if (IN(2)) REPS(2) {
        pg8::Gemm g{U, WIN_T, M + MC, DIN, DM}; pg8::OrderIn S; S.init(G, bx);
        pg8::EpiIn E{Q, KA, VA, Z, UG, ROPE, qnw, knw};
        pg8::gemm_phase<pg8::EpiIn, pg8::OrderIn, true, true>(ldsl, g, S, E);
    }
    SEAM(2);
    if (IN(3)) REPS(3) conv_phase(ldsl, UG, convw, convb, lnw, lnb, Y, vcu, G, tid);
    SEAM(3);
    if (IN(4)) REPS(4) {
        const attn_body::AttnTensors AT{(const attn_body::bf16*)Q, (const attn_body::bf16*)KA, (const attn_body::bf16*)VA, (const attn_body::bf16*)Z, (attn_body::bf16*)MIX};
        float mq = 0.f, mk = 0.f;
        for (int d = 0; d < 64; ++d) { mq = fmaxf(mq, fabsf(qnw[d])); mk = fmaxf(mk, fabsf(knw[d])); }
        const float mfix = 1.02f * 64.0f * pg8::QC2 * mq * mk;
        if (mfix <= 60.0f) attn_body::attn_phase<8, true>((char*)lds, AT, vcu, G, mfix);
        else               attn_body::attn_phase<8, false>((char*)lds, AT, vcu, G, 0.f);
        pg8::Gemm g{Y, WPW_T, M, DCONV, DCONV}; pg8::StaticOrder S; S.init(M, DCONV, G, bx);
        pg8::EpiPw E{Z, MIX, bpw};
        pg8::gemm_phase<pg8::EpiPw, pg8::StaticOrder, true, true>(ldsl, g, S, E);
    }
    SEAM(4);
    if (IN(5)) REPS(5) {
        pg8::Gemm g{MIX, WOUT_T, M, DM, DM}; pg8::StaticOrder S; S.init(M, DM, G, bx);
        pg8::EpiOut E{x, args.out, MOD};
        pg8::gemm_phase<pg8::EpiOut, pg8::StaticOrder, true, true>(ldsl, g, S, E);
    }
#undef IN
#undef SEAM
}

extern "C" void kernel_launch(void* const* d_in, const int* in_sizes, int n_in, void* d_out, int out_size, void* d_ws, size_t ws_size, hipStream_t stream) {
    static int grid = 0;
    if (grid == 0) {
        if (n_in != 17 || in_sizes[0] != M * DM || out_size != M * DM || ws_size < WS_END) { fprintf(stderr, "kernel_launch: unexpected shapes (n_in %d, in0 %d, out %d, ws %zu); nothing launched\n", n_in, n_in > 0 ? in_sizes[0] : -1, out_size, ws_size); grid = -1; return; }
        int dev = 0, cus = 0, per_cu = 0;
        if (hipGetDevice(&dev) != hipSuccess || hipDeviceGetAttribute(&cus, hipDeviceAttributeMultiprocessorCount, dev) != hipSuccess) { grid = -1; return; }
        if (hipFuncSetAttribute((const void*)hybrid_fwd, hipFuncAttributeMaxDynamicSharedMemorySize, LDS_BYTES) != hipSuccess) { fprintf(stderr, "kernel_launch: hipFuncSetAttribute failed\n"); grid = -1; return; }
        if (hipOccupancyMaxActiveBlocksPerMultiprocessor(&per_cu, (const void*)hybrid_fwd, NWAVES * 64, LDS_BYTES) != hipSuccess || per_cu < 1) { fprintf(stderr, "kernel_launch: occupancy query says %d\n", per_cu); per_cu = 1; }
        (void)hipGetLastError();
        grid = cus * per_cu;
    }
    if (grid < 0) return;
    if (hipMemsetAsync((char*)d_ws + WS_CTL, 0, CTL_ZERO_BYTES, stream) != hipSuccess) { fprintf(stderr, "kernel_launch: memset failed\n"); return; }
    Args a{};
    for (int i = 0; i < 17; ++i) a.in[i] = (const float*)d_in[i];
    a.out = (float*)d_out; a.ws = (unsigned char*)d_ws;
#if MK_N_LAUNCHES == 1
    a.ph_lo = 0; a.ph_hi = N_PHASES;
    void* kargs[] = {&a};
    hipError_t e = hipLaunchCooperativeKernel((const void*)hybrid_fwd, dim3(grid), dim3(NWAVES * 64), kargs, LDS_BYTES, stream);
    if (e != hipSuccess) fprintf(stderr, "kernel_launch: cooperative launch failed: %s (grid %d)\n", hipGetErrorString(e), grid);
#else
    for (int p = 0; p < N_PHASES; ++p) { a.ph_lo = p; a.ph_hi = p + 1; hipLaunchKernelGGL(hybrid_fwd, dim3(grid), dim3(NWAVES * 64), LDS_BYTES, stream, a); }
#endif
}
```

```cpp
#include <hip/hip_runtime.h>
#include <hip/hip_cooperative_groups.h>
#include <cstdio>
#include <cstdint>
namespace pg8 {
#define PG8_LAS __attribute__((address_space(3)))
typedef unsigned short bf16_t;
typedef short bf16x8 __attribute__((ext_vector_type(8)));
typedef float f32x4 __attribute__((ext_vector_type(4)));
typedef unsigned u32x4 __attribute__((ext_vector_type(4)));
constexpr int BM = 256, BK = 64, HALF = 128, HTB = HALF * BK * 2  , STAGE_BYTES = 8 * HTB, NXCD = 8, WGM = 8;

__host__ __device__ __forceinline__ int lds_byte(int r, int c) { const int st = (r >> 4) * 2 + (c >> 5), rr = r & 15, cc = c & 31, ob = rr * 64 + cc * 2; return st * 1024 + (ob ^ (((ob >> 9) & 1) << 5)); }
__host__ __device__ __forceinline__ void stage_rc(int b, int& R, int& C) { const int st = b / 1024, sb = b % 1024, swz = sb ^ (((sb >> 9) & 1) << 5); R = (st >> 1) * 16 + swz / 64; C = (st & 1) * 32 + (swz % 64) / 2; }
__host__ __device__ __forceinline__ int perm32(int rho) { const int n = rho >> 4, i = rho & 15; return 8 * (i >> 2) + 4 * n + (i & 3); }

struct Unit { int pm, pn; };
struct Gemm { const bf16_t* A; const bf16_t* Bt; int M, N, K; };

struct StaticOrder {
    int nM, nN, nwg, G, c;
    __host__ __device__ void init(int M, int N, int G_, int c_) { nM = M / BM; nN = N / BM; nwg = nM * nN; G = G_; c = c_; }
    __host__ __device__ bool next(int i, Unit& u) const {
        const long L = (long)i * G + c; if (L >= nwg) return false;
        int wgid = (int)L; { const int q = nwg / NXCD, r = nwg % NXCD, xcd = wgid % NXCD, off = wgid / NXCD; wgid = (xcd < r ? xcd * (q + 1) : r * (q + 1) + (xcd - r) * q) + off; }
        const int nig = WGM * nN, gid = wgid / nig, fm = gid * WGM, gsz = (nM - fm) < WGM ? (nM - fm) : WGM;
        u.pm = fm + ((wgid % nig) % gsz); u.pn = (wgid % nig) / gsz; return true;
    }
    __device__ __forceinline__ void a_ready(const Unit&) const {}
    __device__ __forceinline__ void done(const Unit&) const {}
};
__device__ __forceinline__ unsigned cvt_pk_bf16(float lo, float hi) { unsigned r; asm volatile("v_cvt_pk_bf16_f32 %0, %1, %2" : "=v"(r) : "v"(lo), "v"(hi)); return r; }
typedef float f32x2 __attribute__((ext_vector_type(2)));
constexpr float QC2 = 0.125f * 1.4426950408889634f;
__device__ __forceinline__ float silu_f(float v) { return v * __builtin_amdgcn_rcpf(1.0f + __expf(-v)); }
__device__ __forceinline__ float sigm_f(float v) { return __builtin_amdgcn_rcpf(1.0f + __expf(-v)); }
__device__ __forceinline__ float bf_lo(unsigned w) { return __uint_as_float(w << 16); }
__device__ __forceinline__ float bf_hi(unsigned w) { return __uint_as_float(w & 0xffff0000u); }

template <int CTRL> __device__ __forceinline__ float dpp_mov(float v) { return __int_as_float(__builtin_amdgcn_update_dpp(0, __float_as_int(v), CTRL, 0xF, 0xF, true)); }
__device__ __forceinline__ float xor16_sum(float v) { auto r = __builtin_amdgcn_permlane16_swap(__float_as_uint(v), __float_as_uint(v), false, false); return __uint_as_float(r[0]) + __uint_as_float(r[1]); }
__device__ __forceinline__ float xor32_sum(float v) { auto r = __builtin_amdgcn_permlane32_swap(__float_as_uint(v), __float_as_uint(v), false, false); return __uint_as_float(r[0]) + __uint_as_float(r[1]); }
__device__ __forceinline__ float wave_allsum(float v) {
    v += dpp_mov<0xB1>(v); v += dpp_mov<0x4E>(v); v += dpp_mov<0x141>(v); v += dpp_mov<0x140>(v);
    return xor32_sum(xor16_sum(v));
}
struct OrderIn {
    StaticOrder so;
    __device__ void init(int G_, int c_) { so.init(32768, 2816, G_, c_); }
    __device__ bool next(int i, Unit& u) const {
        const long L = (long)i * so.G + so.c;
        if (L < so.nwg) return so.next(i, u);
        const int e = (int)(L - so.nwg); if (e >= 16) return false;
        u.pm = 128 + e; u.pn = 2; return true;
    }
    __device__ __forceinline__ void a_ready(const Unit&) const {}
    __device__ __forceinline__ void done(const Unit&) const {}
};

struct EpiIn {
    static constexpr bool PERM = true, AFTER_DRAIN = false;
    bf16_t *Q, *KA, *VA, *Z, *UG; const float* rope; const float *qnw, *knw;
    __device__ __forceinline__ void operator()(const f32x4 (&acc)[2][2][4][2], const Unit& u, int wr, int wc, int fr, int fq) const {
        const int pn = u.pn;
        const int rowb = u.pm * BM + wr * 64 + fr;
        if (pn <= 2) {
            const bool isq = pn < 2, isv = (pn == 2) && (wc >= 2), isctx = u.pm >= 128;
            const int d1 = (fq & 1) * 8 + (fq >> 1) * 32;
            float w1[8], w2[8];
            { const float* nw = isq ? qnw : knw; const float sc = isq ? QC2 : 1.0f;
#pragma unroll
              for (int e = 0; e < 8; ++e) { w1[e] = nw[d1 + e] * sc; w2[e] = nw[d1 + 16 + e] * sc; } }
#pragma unroll
            for (int ai = 0; ai < 2; ++ai)
#pragma unroll
                for (int m = 0; m < 4; ++m) {
                    const int row = rowb + ai * HALF + m * 16;
                    float x1[8], x2[8];
#pragma unroll
                    for (int n = 0; n < 2; ++n)
#pragma unroll
                        for (int i = 0; i < 4; ++i) { x1[4 * n + i] = acc[ai][0][m][n][i]; x2[4 * n + i] = acc[ai][1][m][n][i]; }
                    bf16_t* dst;
                    if (isq) dst = Q + (size_t)row * 512 + (4 * pn + wc) * 64 + d1;
                    else {
                        size_t pos;
                        if (isctx) { const int r2 = row - 32768; pos = (size_t)(r2 >> 8) * 2304 + (r2 & 255); }
                        else pos = (size_t)(row >> 11) * 2304 + 256 + (row & 2047);
                        dst = (isv ? VA : KA) + pos * 128 + (wc & 1) * 64 + d1;
                    }
                    if (!isv) {
                        float ss = 0.f;
#pragma unroll
                        for (int e = 0; e < 8; ++e) ss += x1[e] * x1[e] + x2[e] * x2[e];
                        ss = xor32_sum(xor16_sum(ss));
                        const float rinv = rsqrtf(ss * (1.0f / 64.0f) + 1e-6f);
#pragma unroll
                        for (int e = 0; e < 8; ++e) { x1[e] = x1[e] * rinv * w1[e]; x2[e] = x2[e] * rinv * w2[e]; }
                        if (!isctx) {
                            const int t = row & 2047, pos = (fq >> 1) ? (t & 63) : (t >> 6);
                            const f32x4* rp = (const f32x4*)(rope + (size_t)(pos * 16 + (fq & 1) * 8) * 2);
#pragma unroll
                            for (int e2 = 0; e2 < 4; ++e2) { const f32x4 cs = rp[e2];
                                { const float a = x1[2 * e2], b = x2[2 * e2]; x1[2 * e2] = a * cs[0] - b * cs[1]; x2[2 * e2] = a * cs[1] + b * cs[0]; }
                                { const float a = x1[2 * e2 + 1], b = x2[2 * e2 + 1]; x1[2 * e2 + 1] = a * cs[2] - b * cs[3]; x2[2 * e2 + 1] = a * cs[3] + b * cs[2]; } }
                        }
                    }
                    u32x4 o1, o2;
                    o1.x = cvt_pk_bf16(x1[0], x1[1]); o1.y = cvt_pk_bf16(x1[2], x1[3]); o1.z = cvt_pk_bf16(x1[4], x1[5]); o1.w = cvt_pk_bf16(x1[6], x1[7]);
                    o2.x = cvt_pk_bf16(x2[0], x2[1]); o2.y = cvt_pk_bf16(x2[2], x2[3]); o2.z = cvt_pk_bf16(x2[4], x2[5]); o2.w = cvt_pk_bf16(x2[6], x2[7]);
                    *(u32x4*)dst = o1; *(u32x4*)(dst + 16) = o2;
                }
        } else if (pn >= 5 && pn <= 8) {
            const int c0 = (pn - 5) * 128 + wc * 32 + 8 * fq;
#pragma unroll
            for (int ai = 0; ai < 2; ++ai)
#pragma unroll
                for (int m = 0; m < 4; ++m) {
                    const int row = rowb + ai * HALF + m * 16;
                    const f32x4 a0 = acc[ai][0][m][0], a1 = acc[ai][0][m][1], g0 = acc[ai][1][m][0], g1 = acc[ai][1][m][1];
                    u32x4 w;
                    w.x = cvt_pk_bf16(a0[0] * sigm_f(g0[0]), a0[1] * sigm_f(g0[1])); w.y = cvt_pk_bf16(a0[2] * sigm_f(g0[2]), a0[3] * sigm_f(g0[3]));
                    w.z = cvt_pk_bf16(a1[0] * sigm_f(g1[0]), a1[1] * sigm_f(g1[1])); w.w = cvt_pk_bf16(a1[2] * sigm_f(g1[2]), a1[3] * sigm_f(g1[3]));
                    *(u32x4*)(UG + (size_t)row * 512 + c0) = w;
                }
        } else {
            const int zc = (pn <= 4 ? (pn - 3) * 256 : 512 + (pn - 9) * 256) + wc * 32 + 8 * fq;
#pragma unroll
            for (int ai = 0; ai < 2; ++ai)
#pragma unroll
                for (int m = 0; m < 4; ++m) {
                    const int row = rowb + ai * HALF + m * 16;
#pragma unroll
                    for (int bj = 0; bj < 2; ++bj) { const f32x4 v0 = acc[ai][bj][m][0], v1 = acc[ai][bj][m][1];
                        u32x4 w; w.x = cvt_pk_bf16(silu_f(v0[0]), silu_f(v0[1])); w.y = cvt_pk_bf16(silu_f(v0[2]), silu_f(v0[3]));
                        w.z = cvt_pk_bf16(silu_f(v1[0]), silu_f(v1[1])); w.w = cvt_pk_bf16(silu_f(v1[2]), silu_f(v1[3]));
                        *(u32x4*)(Z + (size_t)row * 1024 + zc + bj * HALF) = w; }
                }
        }
    }
};

struct EpiPw {
    static constexpr bool PERM = true, AFTER_DRAIN = false;
    const bf16_t* Z; bf16_t* MIX; const float* bias;
    __device__ __forceinline__ void operator()(const f32x4 (&acc)[2][2][4][2], const Unit& u, int wr, int wc, int fr, int fq) const {
        const int rowb = u.pm * BM + wr * 64 + fr, col0 = u.pn * BM + wc * 32 + 8 * fq;
        f32x4 bv[2][2];
#pragma unroll
        for (int bj = 0; bj < 2; ++bj)
#pragma unroll
            for (int n = 0; n < 2; ++n) bv[bj][n] = *(const f32x4*)(bias + col0 + bj * HALF + 4 * n);
        u32x4 zz[2][4][2];
#pragma unroll
        for (int ai = 0; ai < 2; ++ai)
#pragma unroll
            for (int m = 0; m < 4; ++m) { const size_t off = (size_t)(rowb + ai * HALF + m * 16) * 1024 + 512 + col0;
#pragma unroll
                for (int bj = 0; bj < 2; ++bj) zz[ai][m][bj] = *(const u32x4*)(Z + off + bj * HALF); }
        asm volatile("" ::: "memory");
#pragma unroll
        for (int ai = 0; ai < 2; ++ai)
#pragma unroll
            for (int m = 0; m < 4; ++m) {
                const size_t off = (size_t)(rowb + ai * HALF + m * 16) * 1024 + 512 + col0;
#pragma unroll
                for (int bj = 0; bj < 2; ++bj) {
                    const u32x4 z = zz[ai][m][bj];
                    const f32x4 v0 = acc[ai][bj][m][0] + bv[bj][0], v1 = acc[ai][bj][m][1] + bv[bj][1];
                    u32x4 w;
                    w.x = cvt_pk_bf16(v0[0] * bf_lo(z.x), v0[1] * bf_hi(z.x)); w.y = cvt_pk_bf16(v0[2] * bf_lo(z.y), v0[3] * bf_hi(z.y));
                    w.z = cvt_pk_bf16(v1[0] * bf_lo(z.z), v1[1] * bf_hi(z.z)); w.w = cvt_pk_bf16(v1[2] * bf_lo(z.w), v1[3] * bf_hi(z.w));
                    *(u32x4*)(MIX + off + bj * HALF) = w;
                }
            }
    }
};

struct EpiOut {
    static constexpr bool PERM = false, AFTER_DRAIN = false;
    const float* x; float* out; const float* mod;
    __device__ __forceinline__ void operator()(const f32x4 (&acc)[2][2][4][2], const Unit& u, int wr, int wc, int fr, int fq) const {
        const int rowb = u.pm * BM + wr * 64 + fr, col0 = u.pn * BM + wc * 32 + 4 * fq;
        const float* gp = mod + (size_t)(u.pm >> 3) * 3072 + 2048 + col0;
        f32x4 gv[2][2];
#pragma unroll
        for (int bj = 0; bj < 2; ++bj)
#pragma unroll
            for (int n = 0; n < 2; ++n) gv[bj][n] = *(const f32x4*)(gp + bj * HALF + n * 16);
        const float* __restrict__ xr_ = x; float* __restrict__ or_ = out;
#pragma unroll
        for (int ai = 0; ai < 2; ++ai) {
            f32x4 xv[4][2][2];
#pragma unroll
            for (int m = 0; m < 4; ++m) { const size_t off = (size_t)(rowb + ai * HALF + m * 16) * 1024 + col0;
#pragma unroll
                for (int bj = 0; bj < 2; ++bj)
#pragma unroll
                    for (int n = 0; n < 2; ++n) xv[m][bj][n] = *(const f32x4*)(xr_ + off + bj * HALF + n * 16); }
            asm volatile("" ::: "memory");
#pragma unroll
            for (int m = 0; m < 4; ++m) { const size_t off = (size_t)(rowb + ai * HALF + m * 16) * 1024 + col0;
#pragma unroll
                for (int bj = 0; bj < 2; ++bj)
#pragma unroll
                    for (int n = 0; n < 2; ++n) *(f32x4*)(or_ + off + bj * HALF + n * 16) = xv[m][bj][n] + gv[bj][n] * acc[ai][bj][m][n]; }
            asm volatile("" ::: "memory");
        }
    }
};
template <class Epi, class Sched, bool ALIGN_EPI = false, bool SP2 = false>
__device__ __forceinline__ void gemm_phase(PG8_LAS unsigned char* lds, const Gemm g, const Sched& S, const Epi& E) {
    const int tid = threadIdx.x, wid = __builtin_amdgcn_readfirstlane(tid >> 6), lane = tid & 63, wr = wid >> 2, wc = wid & 3, fr = lane & 15, fq = lane >> 4;
    const int K = g.K, nt = K / BK;
    unsigned voffA[2], voffB[2];
#pragma unroll
    for (int i = 0; i < 2; ++i) { int R, C; stage_rc(tid * 16 + i * 8192, R, C); const int Rb = Epi::PERM ? ((R & ~31) + perm32(R & 31)) : R;
        voffA[i] = (unsigned)(R * K + C) * 2u; voffB[i] = (unsigned)(Rb * K + C) * 2u; }
    const size_t kstep = (size_t)(BK * 2);
    const size_t hstep = (size_t)HALF * K * 2;
    const size_t tstep = 2 * hstep;
    const unsigned ldsw = (unsigned)wid * 1024u;
    const int aoff = lds_byte(wr * 64 + fr, fq * 8), boff = lds_byte(wc * 32 + fr, fq * 8);
#define PG8_SA(b, h) (((b) * 2 + (h)) * HTB)
#define PG8_SB(b, h) ((4 + (b) * 2 + (h)) * HTB)
#define PG8_STAGE(bufoff, gbase, voff) do { _Pragma("unroll") for (int _i = 0; _i < 2; ++_i) \
        __builtin_amdgcn_global_load_lds((const unsigned*)((const char*)(gbase) + (voff)[_i]), (PG8_LAS unsigned*)(lds + (bufoff) + ldsw + _i * 8192), 16, 0, 0); } while (0)
#define PG8_LDA(dst, b, h) do { _Pragma("unroll") for (int m = 0; m < 4; ++m) _Pragma("unroll") for (int k = 0; k < 2; ++k) dst[m][k] = *(const PG8_LAS bf16x8*)(lds + PG8_SA(b, h) + aoff + m * 2048 + k * 1024); } while (0)
#define PG8_LDB(dst, b, h) do { _Pragma("unroll") for (int n = 0; n < 2; ++n) _Pragma("unroll") for (int k = 0; k < 2; ++k) dst[n][k] = *(const PG8_LAS bf16x8*)(lds + PG8_SB(b, h) + boff + n * 2048 + k * 1024); } while (0)
#define PG8_MMA(ai, bj, At, Bt) do { __builtin_amdgcn_s_setprio(1); _Pragma("unroll") for (int m = 0; m < 4; ++m) _Pragma("unroll") for (int n = 0; n < 2; ++n) _Pragma("unroll") for (int k = 0; k < 2; ++k) \
        acc[ai][bj][m][n] = __builtin_amdgcn_mfma_f32_16x16x32_bf16(Bt[n][k], At[m][k], acc[ai][bj][m][n], 0, 0, 0); __builtin_amdgcn_s_setprio(0); } while (0)
#define PG8_WAIT_V(n) asm volatile("s_waitcnt vmcnt(" #n ")" ::: "memory")
#define PG8_WAIT_L(n) asm volatile("s_waitcnt lgkmcnt(" #n ")" ::: "memory")
#define PG8_BAR __builtin_amdgcn_s_barrier()
#define PG8_SCHED __builtin_amdgcn_sched_barrier(0)
    Unit cur, nxt; int ui = 0;
    if (!S.next(0, cur)) return;
    f32x4 acc[2][2][4][2];
#pragma unroll
    for (int a = 0; a < 2; ++a)
#pragma unroll
        for (int b = 0; b < 2; ++b)
#pragma unroll
            for (int m = 0; m < 4; ++m)
#pragma unroll
                for (int n = 0; n < 2; ++n) acc[a][b][m][n] = (f32x4){0.f, 0.f, 0.f, 0.f};
    bf16x8 At[4][2], B0[2][2], B1[2][2];
    const char* cA = (const char*)g.A + (size_t)cur.pm * tstep; const char* cB = (const char*)g.Bt + (size_t)cur.pn * tstep;
    S.a_ready(cur);
    if constexpr (SP2) {
        PG8_STAGE(PG8_SB(0, 0), cB, voffB); PG8_STAGE(PG8_SB(0, 1), cB + hstep, voffB); PG8_STAGE(PG8_SA(0, 0), cA, voffA); PG8_STAGE(PG8_SA(0, 1), cA + hstep, voffA);
        if (wr == 1) PG8_BAR;
        PG8_WAIT_V(2); PG8_BAR;
        PG8_STAGE(PG8_SB(1, 0), cB + kstep, voffB); PG8_STAGE(PG8_SA(1, 0), cA + kstep, voffA); PG8_STAGE(PG8_SB(1, 1), cB + hstep + kstep, voffB);
        PG8_WAIT_V(6); PG8_BAR;
    } else {
        PG8_STAGE(PG8_SB(0, 0), cB, voffB); PG8_STAGE(PG8_SA(0, 0), cA, voffA); PG8_STAGE(PG8_SB(0, 1), cB + hstep, voffB); PG8_STAGE(PG8_SA(0, 1), cA + hstep, voffA);
        if (wr == 1) PG8_BAR;
        PG8_WAIT_V(4); PG8_BAR;
        PG8_STAGE(PG8_SB(1, 0), cB + kstep, voffB); PG8_STAGE(PG8_SA(1, 0), cA + kstep, voffA); PG8_STAGE(PG8_SB(1, 1), cB + hstep + kstep, voffB);
        PG8_WAIT_V(6); PG8_BAR;
    }
    for (;;) {
        const bool has_next = S.next(ui + 1, nxt);
        const char* nA = has_next ? (const char*)g.A + (size_t)nxt.pm * tstep : cA; const char* nB = has_next ? (const char*)g.Bt + (size_t)nxt.pn * tstep : cB;
        for (int t = 0; t < nt; t += 2) {
            const bool last = (t == nt - 2);
            const char* a1 = cA + (size_t)(t + 1) * kstep;
            const char* a2 = last ? nA : cA + (size_t)(t + 2) * kstep; const char* b2 = last ? nB : cB + (size_t)(t + 2) * kstep;
            const char* a3 = a2 + kstep; const char* b3 = b2 + kstep;
            if (last && has_next) S.a_ready(nxt);
            if constexpr (SP2) {
            PG8_LDB(B0, 0, 0); PG8_LDB(B1, 0, 1); PG8_SCHED; PG8_LDA(At, 0, 0); PG8_STAGE(PG8_SA(1, 1), a1 + hstep, voffA);
            PG8_WAIT_V(8); PG8_WAIT_L(0); PG8_BAR; PG8_MMA(0, 0, At, B0); PG8_MMA(0, 1, At, B1); PG8_BAR; PG8_SCHED;
            PG8_LDA(At, 0, 1); PG8_STAGE(PG8_SB(0, 0), b2, voffB); PG8_STAGE(PG8_SB(0, 1), b2 + hstep, voffB); PG8_STAGE(PG8_SA(0, 0), a2, voffA);
            PG8_WAIT_V(8); PG8_WAIT_L(0); PG8_BAR; PG8_MMA(1, 0, At, B0); PG8_MMA(1, 1, At, B1); PG8_BAR; PG8_SCHED;
            PG8_LDB(B0, 1, 0); PG8_LDB(B1, 1, 1); PG8_SCHED; PG8_LDA(At, 1, 0); PG8_STAGE(PG8_SA(0, 1), a2 + hstep, voffA);
            PG8_WAIT_V(8); PG8_WAIT_L(0); PG8_BAR; PG8_MMA(0, 0, At, B0); PG8_MMA(0, 1, At, B1); PG8_BAR; PG8_SCHED;
            PG8_LDA(At, 1, 1); PG8_STAGE(PG8_SB(1, 0), b3, voffB); PG8_STAGE(PG8_SB(1, 1), b3 + hstep, voffB); PG8_STAGE(PG8_SA(1, 0), a3, voffA);
            PG8_WAIT_V(8); PG8_WAIT_L(0); PG8_BAR; PG8_MMA(1, 0, At, B0); PG8_MMA(1, 1, At, B1); PG8_BAR; PG8_SCHED;
            } else {
            PG8_LDB(B0, 0, 0); PG8_SCHED; PG8_LDA(At, 0, 0); PG8_STAGE(PG8_SA(1, 1), a1 + hstep, voffA);
            PG8_WAIT_L(8); PG8_BAR; PG8_WAIT_L(0); PG8_MMA(0, 0, At, B0); PG8_BAR; PG8_SCHED;
            PG8_LDB(B1, 0, 1); PG8_STAGE(PG8_SB(0, 0), b2, voffB);
            PG8_BAR; PG8_WAIT_L(0); PG8_MMA(0, 1, At, B1); PG8_BAR;
            PG8_LDA(At, 0, 1); PG8_STAGE(PG8_SA(0, 0), a2, voffA);
            PG8_BAR; PG8_WAIT_L(0); PG8_MMA(1, 0, At, B0); PG8_BAR; PG8_SCHED;
            PG8_STAGE(PG8_SB(0, 1), b2 + hstep, voffB);
            PG8_WAIT_V(6); PG8_BAR; PG8_MMA(1, 1, At, B1); PG8_BAR;
            PG8_LDB(B0, 1, 0); PG8_SCHED; PG8_LDA(At, 1, 0); PG8_STAGE(PG8_SA(0, 1), a2 + hstep, voffA);
            PG8_WAIT_L(8); PG8_BAR; PG8_WAIT_L(0); PG8_MMA(0, 0, At, B0); PG8_BAR; PG8_SCHED;
            PG8_LDB(B1, 1, 1); PG8_STAGE(PG8_SB(1, 0), b3, voffB);
            PG8_BAR; PG8_WAIT_L(0); PG8_MMA(0, 1, At, B1); PG8_BAR;
            PG8_LDA(At, 1, 1); PG8_STAGE(PG8_SA(1, 0), a3, voffA);
            PG8_BAR; PG8_WAIT_L(0); PG8_MMA(1, 0, At, B0); PG8_BAR; PG8_SCHED;
            PG8_STAGE(PG8_SB(1, 1), b3 + hstep, voffB);
            PG8_WAIT_V(6); PG8_BAR; PG8_MMA(1, 1, At, B1); PG8_BAR;
            }
        }
        if constexpr (ALIGN_EPI) { if (wr == 0) PG8_BAR; }
        if constexpr (!Epi::AFTER_DRAIN) { E(acc, cur, wr, wc, fr, fq); S.done(cur); }
        if (!has_next) break;
#pragma unroll
        for (int a = 0; a < 2; ++a)
#pragma unroll
            for (int b = 0; b < 2; ++b)
#pragma unroll
                for (int m = 0; m < 4; ++m)
#pragma unroll
                    for (int n = 0; n < 2; ++n) acc[a][b][m][n] = (f32x4){0.f, 0.f, 0.f, 0.f};
        cur = nxt; cA = nA; cB = nB; ++ui;
        if constexpr (ALIGN_EPI) { if (wr == 1) PG8_BAR; }
    }
    PG8_WAIT_V(0);
    if constexpr (!ALIGN_EPI) { if (wr == 0) PG8_BAR; }
    PG8_BAR;
    if constexpr (Epi::AFTER_DRAIN) { E.fused(acc, cur, wr, wc, fr, fq, lds, wid, lane); S.done(cur); }
#undef PG8_SA
#undef PG8_SB
#undef PG8_STAGE
#undef PG8_LDA
#undef PG8_LDB
#undef PG8_MMA
#undef PG8_WAIT_V
#undef PG8_WAIT_L
#undef PG8_BAR
#undef PG8_SCHED
}
}
#include <hip/hip_bf16.h>
#include <cmath>
namespace attn_body {
using bf16=__hip_bfloat16;
using bf16x8=__attribute__((ext_vector_type(8)))short;
using s16x4=__attribute__((ext_vector_type(4)))short;
using f32x16=__attribute__((ext_vector_type(16)))float;
using u32x4=__attribute__((ext_vector_type(4)))unsigned;
constexpr int SEQ=2048,SKV=2304,D=64,QP=512,KP=128,OP=1024;
constexpr int NW=8,QBLK=32,QB=QBLK*NW,KVBLK=64,NQB=SEQ/QB;
constexpr int ATTN_UNIT_ROWS=QB;
__device__ __forceinline__ int crow(int r,int hi){return (r&3)+8*(r>>2)+4*hi;}
#define SBAR() __builtin_amdgcn_sched_barrier(0)
__device__ __forceinline__ void cmask(f32x16&p0,f32x16&p1,int jb,int qrel,int hi){
  const float NEG=-INFINITY; int kb=64*jb+4*hi;
  #pragma unroll
  for(int r=0;r<16;++r){int kv=kb+(r&3)+8*(r>>2); if(kv>qrel)p0[r]=NEG; if(kv+32>qrel)p1[r]=NEG;}
}

constexpr int NSLOT=3, SLOTB=8192;
constexpr int LDS_K=0, LDS_V=NSLOT*SLOTB, LDS_WS=2*NSLOT*SLOTB, LDS_OST=LDS_WS+NW*64*4, LDS_BYTES=LDS_OST+NW*4096;
constexpr float C2=0.125f*1.4426950408889634f;
__device__ __forceinline__ void glds16(const void*gsrc,unsigned lds_dst){unsigned keep;
  asm volatile("s_mov_b32 %0, m0\n\ts_mov_b32 m0, %2\n\ts_nop 0\n\tglobal_load_lds_dwordx4 %1, off\n\ts_mov_b32 m0, %0":"=&s"(keep):"v"(gsrc),"s"(lds_dst):"memory");}
__device__ __forceinline__ float max3f(float a,float b,float c){float r;asm("v_max3_f32 %0, %1, %2, %3":"=v"(r):"v"(a),"v"(b),"v"(c));return r;}
__device__ __forceinline__ float max2f(float a,float b){float r;asm("v_max_f32_e32 %0, %1, %2":"=v"(r):"v"(a),"v"(b));return r;}
__device__ __forceinline__ float fadd_s(float a,float b){float r;asm("v_add_f32_e32 %0, %1, %2":"=v"(r):"v"(a),"v"(b));return r;}
__device__ __forceinline__ float fsub_s(float a,float b){float r;asm("v_sub_f32_e32 %0, %1, %2":"=v"(r):"v"(a),"v"(b));return r;}
typedef float f32x2_t __attribute__((ext_vector_type(2))); typedef __bf16 bf16x2_t __attribute__((ext_vector_type(2)));
__device__ __forceinline__ unsigned cvtpk_s(float lo,float hi){f32x2_t v={lo,hi};bf16x2_t b=__builtin_convertvector(v,bf16x2_t);return __builtin_bit_cast(unsigned,b);}
#define WAIT_BAR(N) asm volatile("s_waitcnt vmcnt(" #N ") lgkmcnt(0)\n\ts_barrier":::"memory")

__device__ __forceinline__ void qkt(f32x16&p0,f32x16&p1,const char*Kslot,const bf16x8*qr,const f32x16&negm,int r32,int hi){
  const char*kb=Kslot+hi*1024+r32*16;
  #pragma unroll
  for(int d0=0;d0<4;++d0){
    const bf16x8 b0=*reinterpret_cast<const bf16x8*>(kb+d0*2048);
    const bf16x8 b1=*reinterpret_cast<const bf16x8*>(kb+d0*2048+512);
    if(d0==0){p0=__builtin_amdgcn_mfma_f32_32x32x16_bf16(b0,qr[0],negm,0,0,0);p1=__builtin_amdgcn_mfma_f32_32x32x16_bf16(b1,qr[0],negm,0,0,0);}
    else{p0=__builtin_amdgcn_mfma_f32_32x32x16_bf16(b0,qr[d0],p0,0,0,0);p1=__builtin_amdgcn_mfma_f32_32x32x16_bf16(b1,qr[d0],p1,0,0,0);}}
}
typedef __attribute__((address_space(3))) const char* lds_cptr;
typedef short v4i16_t __attribute__((ext_vector_type(4)));
__device__ __forceinline__ void kload8(bf16x8*kf,lds_cptr kp){
  kf[0]=*(const __attribute__((address_space(3))) bf16x8*)(kp);      kf[1]=*(const __attribute__((address_space(3))) bf16x8*)(kp+512);
  kf[2]=*(const __attribute__((address_space(3))) bf16x8*)(kp+2048); kf[3]=*(const __attribute__((address_space(3))) bf16x8*)(kp+2560);
  kf[4]=*(const __attribute__((address_space(3))) bf16x8*)(kp+4096); kf[5]=*(const __attribute__((address_space(3))) bf16x8*)(kp+4608);
  kf[6]=*(const __attribute__((address_space(3))) bf16x8*)(kp+6144); kf[7]=*(const __attribute__((address_space(3))) bf16x8*)(kp+6656);
}
__device__ __forceinline__ void kload2(bf16x8*kf,lds_cptr kp,int j){ kf[2*j]=*(const __attribute__((address_space(3))) bf16x8*)(kp+j*2048); kf[2*j+1]=*(const __attribute__((address_space(3))) bf16x8*)(kp+j*2048+512); }
__device__ __forceinline__ s16x4 vtr(lds_cptr p){ return __builtin_bit_cast(s16x4,__builtin_amdgcn_ds_read_tr16_b64_v4i16((__attribute__((address_space(3))) v4i16_t*)p)); }
__device__ __forceinline__ float rowmax(const f32x16&p0,const f32x16&p1){
  float a=max3f(p0[0],p0[1],p1[0]),b=max3f(p0[2],p0[3],p1[1]);a=max3f(a,p1[2],p1[3]);
  #pragma unroll
  for(int r=4;r<16;r+=4){a=max3f(a,p0[r],p0[r+1]);b=max3f(b,p0[r+2],p0[r+3]);a=max3f(a,p1[r],p1[r+1]);b=max3f(b,p1[r+2],p1[r+3]);}
  const float m=max2f(a,b);
  auto rr=__builtin_amdgcn_permlane32_swap(__float_as_uint(m),__float_as_uint(m),false,false);
  return max2f(__uint_as_float(rr[0]),__uint_as_float(rr[1]));
}
__device__ __forceinline__ void pv(f32x16*o,int vb,bf16x8 pa0,bf16x8 pa1,bf16x8 pa2,bf16x8 pa3){
  #pragma unroll
  for(int d0=0;d0<2;++d0){s16x4 lo[4],hi[4];
    #pragma unroll
    for(int ks=0;ks<4;++ks){
      asm volatile("ds_read_b64_tr_b16 %0,%1 offset:%c2":"=&v"(lo[ks]):"v"(vb),"i"(d0*4096+ks*1024):"memory");
      asm volatile("ds_read_b64_tr_b16 %0,%1 offset:%c2":"=&v"(hi[ks]):"v"(vb),"i"(d0*4096+ks*1024+512):"memory");}
    asm volatile("s_waitcnt lgkmcnt(0)":::"memory");SBAR();
    #define PK(k) (bf16x8){lo[k][0],lo[k][1],lo[k][2],lo[k][3],hi[k][0],hi[k][1],hi[k][2],hi[k][3]}
    o[d0]=__builtin_amdgcn_mfma_f32_32x32x16_bf16(pa0,PK(0),o[d0],0,0,0);
    o[d0]=__builtin_amdgcn_mfma_f32_32x32x16_bf16(pa1,PK(1),o[d0],0,0,0);
    o[d0]=__builtin_amdgcn_mfma_f32_32x32x16_bf16(pa2,PK(2),o[d0],0,0,0);
    o[d0]=__builtin_amdgcn_mfma_f32_32x32x16_bf16(pa3,PK(3),o[d0],0,0,0);
    #undef PK
  }
}

#ifndef ATTN_STORE16
#define ATTN_STORE16(p,v) (*(u32x4*)(p)=(v))
#endif
template<int THRL,bool FIX> __device__ __forceinline__ void attn_unit(float mfix,int b,int h,int qb,const bf16*Q,const bf16*__restrict__ K,const bf16*__restrict__ V,const bf16*__restrict__ Z,bf16*O,char*shm){
  const int tid=threadIdx.x,lane=tid&63,r32=lane&31,hi=lane>>5; const int wid=__builtin_amdgcn_readfirstlane(tid>>6);
  const long rowbase=(long)b*SEQ; const int q0=qb*QB;
  const bf16*Qw=Q+(rowbase+q0+wid*QBLK)*QP+h*D;
  const long kvbase=(long)b*SKV*KP+(h>>2)*D; const bf16*Kh=K+kvbase,*Vh=V+kvbase;
  const unsigned lds0=(unsigned)(uintptr_t)shm;
  float*wsf=(float*)(shm+LDS_WS)+wid*64;
  const bf16*ksrc=Kh+(long)lane*KP+wid*8;
  const bf16*vsrc=Vh+(long)(16*(wid&3)+(lane>>2))*KP+(wid>>2)*32+(lane&3)*8;
  const unsigned kdst=lds0+LDS_K+wid*1024, vdst=lds0+LDS_V+wid*1024;
  #define DMA_K(t,slot) glds16(ksrc+(long)(t)*KVBLK*KP,(unsigned)__builtin_amdgcn_readfirstlane(kdst+(slot)))
  #define DMA_V(t,slot) glds16(vsrc+(long)(t)*KVBLK*KP,(unsigned)__builtin_amdgcn_readfirstlane(vdst+(slot)))
  const int vb0=(int)(lds0+LDS_V)+((lane>>4)&1)*32+(lane&3)*8+(4*hi+((lane&15)>>2))*64;
  const char*Kbase=shm+LDS_K; bf16x8 kf[8];
  const lds_cptr shm3=(lds_cptr)shm; const lds_cptr kp0=shm3+LDS_K+hi*1024+r32*16; const lds_cptr vp0=shm3+LDS_V+((lane>>4)&1)*32+(lane&3)*8+(4*hi+((lane&15)>>2))*64;
  constexpr int NT=SKV/KVBLK;
  DMA_K(0,0);DMA_V(0,0);DMA_K(1,SLOTB);
  bf16x8 qr[4];
  #pragma unroll
  for(int d0=0;d0<4;++d0)qr[d0]=*reinterpret_cast<const bf16x8*>(&Qw[(long)r32*QP+d0*16+hi*8]);
  float mhat=0.f,l_reg=0.f;f32x16 o[2];o[0]=f32x16{};o[1]=f32x16{};f32x16 negm=f32x16{};
  if constexpr(FIX){ mhat=mfix; _Pragma("unroll") for(int r=0;r<16;++r)negm[r]=-mfix; }
  asm volatile("":"+v"(negm));
  const int qrel=wid*QBLK+r32;
  #define CMASK(P0,P1,t) do{}while(0)
  bool resc=false;
  #define START(P0,P1) do{ resc=false; \
    if constexpr(!FIX){ const float rm=rowmax(P0,P1); const float dl=rm; mhat=fadd_s(mhat,dl); \
      _Pragma("unroll") for(int r=0;r<16;++r){P0[r]=fsub_s(P0[r],dl);P1[r]=fsub_s(P1[r],dl);} \
      _Pragma("unroll") for(int r=0;r<16;++r)negm[r]=-mhat; asm volatile("":"+v"(negm)); } \
    _Pragma("unroll") for(int r=0;r<16;++r)P0[r]=__builtin_amdgcn_exp2f(P0[r]); }while(0)
  #define RESC() do{ if(resc){ asm volatile("s_waitcnt lgkmcnt(0)":::"memory"); \
      _Pragma("unroll") for(int d_=0;d_<2;++d_) _Pragma("unroll") for(int r=0;r<16;++r)o[d_][r]*=wsf[crow(r,hi)]; } }while(0)
  f32x16 pA0,pA1,pB0,pB1;
  int sl_prev=0,sl_cur=0,sl_next=SLOTB;
  #define ROT() do{sl_prev=sl_cur;sl_cur=sl_next;sl_next=(sl_next==(NSLOT-1)*SLOTB)?0:sl_next+SLOTB;}while(0)
  DMA_K(2,2*SLOTB);
  WAIT_BAR(3);
  qkt(pA0,pA1,Kbase,qr,negm,r32,hi);asm volatile("s_nop 15\n\ts_nop 7":"+v"(pA0),"+v"(pA1));CMASK(pA0,pA1,0);
  START(pA0,pA1);
  _Pragma("unroll") for(int r=0;r<16;++r)pA1[r]=__builtin_amdgcn_exp2f(pA1[r]);
  WAIT_BAR(0);
  DMA_K(3,0);DMA_V(1,SLOTB);
  ROT();
  kload8(kf,kp0+sl_cur);
  WAIT_BAR(2);
  s16x4 vlo[8],vhi[8]; u32x4 pw0,pw1,pw2,pw3;
  #define PKW(P,B) cvtpk_s(P[B],P[B+1])
  #define PAF(k) __builtin_bit_cast(bf16x8,pw##k)
  #define VFR(i) (bf16x8){vlo[i][0],vlo[i][1],vlo[i][2],vlo[i][3],vhi[i][0],vhi[i][1],vhi[i][2],vhi[i][3]}
  #define PIN(x) asm volatile("":"+v"(x))
  #define MX3(a,b,c) __builtin_fmaxf(__builtin_fmaxf((a),(b)),(c))
  #define GAPA(MF,A0,A1,A2,A3,W0,W1,PW) do{ MF; sacc+=A0; sacc+=A1; sacc+=A2; sacc+=A3; PIN(sacc); W0; W1; PIN(PW); SBAR(); }while(0)
  #define EX(v) __builtin_amdgcn_exp2f(v)
  #define GAPB(MF,X,B) do{ MF; X[B]=EX(X[B]); X[B+1]=EX(X[B+1]); X[B+2]=EX(X[B+2]); X[B+3]=EX(X[B+3]); PIN(X); SBAR(); }while(0)
  #define VRD(i) do{ vlo[i]=vtr(vp_+(((i)>>2)*4096+((i)&3)*1024)); vhi[i]=vtr(vp_+(((i)>>2)*4096+((i)&3)*1024+512)); }while(0)
  #define KRD(G,j) do{ if(G){ kload2(kf,kp0+sl_next,j); SBAR(); } }while(0)
  #define STEP(C0,C1,P0,P1,t,GK,GV,GL) do{ SBAR(); \
    const lds_cptr vp_=vp0+sl_prev; \
    VRD(0); SBAR(); float sacc=(P0[0]+P0[1]); \
    GAPA(C0=__builtin_amdgcn_mfma_f32_32x32x16_bf16(kf[0],qr[0],negm,0,0,0), P0[2],P0[3],P0[4],P0[5],     pw0[0]=PKW(P0,0), pw0[1]=PKW(P0,2), pw0); \
    VRD(4); SBAR(); GAPA(C1=__builtin_amdgcn_mfma_f32_32x32x16_bf16(kf[1],qr[0],negm,0,0,0), P0[6],P0[7],P0[8],P0[9],     pw0[2]=PKW(P0,4), pw0[3]=PKW(P0,6), pw0); \
    VRD(1); SBAR(); GAPA(C0=__builtin_amdgcn_mfma_f32_32x32x16_bf16(kf[2],qr[1],C0,0,0,0),   P0[10],P0[11],P0[12],P0[13], pw1[0]=PKW(P0,8), pw1[1]=PKW(P0,10), pw1); \
    VRD(5); SBAR(); GAPA(C1=__builtin_amdgcn_mfma_f32_32x32x16_bf16(kf[3],qr[1],C1,0,0,0),   P0[14],P0[15],P1[0],P1[1],   pw1[2]=PKW(P0,12),pw1[3]=PKW(P0,14), pw1); \
    VRD(2); SBAR(); GAPA(C0=__builtin_amdgcn_mfma_f32_32x32x16_bf16(kf[4],qr[2],C0,0,0,0),   P1[2],P1[3],P1[4],P1[5],     pw2[0]=PKW(P1,0), pw2[1]=PKW(P1,2), pw2); \
    VRD(6); SBAR(); GAPA(C1=__builtin_amdgcn_mfma_f32_32x32x16_bf16(kf[5],qr[2],C1,0,0,0),   P1[6],P1[7],P1[8],P1[9],     pw2[2]=PKW(P1,4), pw2[3]=PKW(P1,6), pw2); \
    VRD(3); SBAR(); GAPA(C0=__builtin_amdgcn_mfma_f32_32x32x16_bf16(kf[6],qr[3],C0,0,0,0),   P1[10],P1[11],P1[12],P1[13], pw3[0]=PKW(P1,8), pw3[1]=PKW(P1,10), pw3); \
    VRD(7); SBAR(); GAPA(C1=__builtin_amdgcn_mfma_f32_32x32x16_bf16(kf[7],qr[3],C1,0,0,0),   P1[14],P1[15],0.f,0.f,       pw3[2]=PKW(P1,12),pw3[3]=PKW(P1,14), pw3); \
    l_reg+=sacc; \
    if(GK){DMA_K((t)+3,sl_cur);} if(GV){DMA_V((t)+1,sl_next);} \
    CMASK(C0,C1,t); \
    if constexpr(!FIX){ float a=MX3(C0[0],C0[1],C1[0]),b=MX3(C0[2],C0[3],C1[1]); a=MX3(a,C1[2],C1[3]); \
      _Pragma("unroll") for(int r=4;r<16;r+=4){a=MX3(a,C0[r],C0[r+1]);b=MX3(b,C0[r+2],C0[r+3]);a=MX3(a,C1[r],C1[r+1]);b=MX3(b,C1[r+2],C1[r+3]);} \
      float rm=__builtin_fmaxf(a,b); { auto rr=__builtin_amdgcn_permlane32_swap(__float_as_uint(rm),__float_as_uint(rm),false,false); rm=__builtin_fmaxf(__uint_as_float(rr[0]),__uint_as_float(rr[1])); } \
      resc=false; \
      if(__builtin_expect(__any(rm>(float)THRL),0)){ const float dl=__builtin_fmaxf(rm,0.f); mhat+=dl; \
        _Pragma("unroll") for(int r=0;r<16;++r){C0[r]-=dl;C1[r]-=dl;} \
        _Pragma("unroll") for(int r=0;r<16;++r)negm[r]=-mhat; asm volatile("":"+v"(negm)); \
        const float f=__builtin_amdgcn_exp2f(-dl); l_reg*=f; if(hi==0)wsf[r32]=f; resc=true; } } \
    SBAR(); \
    GAPB(o[0]=__builtin_amdgcn_mfma_f32_32x32x16_bf16(PAF(0),VFR(0),o[0],0,0,0), C0,0); \
    GAPB(o[1]=__builtin_amdgcn_mfma_f32_32x32x16_bf16(PAF(0),VFR(4),o[1],0,0,0), C0,4); \
    KRD(GL,0); GAPB(o[0]=__builtin_amdgcn_mfma_f32_32x32x16_bf16(PAF(1),VFR(1),o[0],0,0,0), C0,8); \
    KRD(GL,1); GAPB(o[1]=__builtin_amdgcn_mfma_f32_32x32x16_bf16(PAF(1),VFR(5),o[1],0,0,0), C0,12); \
    KRD(GL,2); GAPB(o[0]=__builtin_amdgcn_mfma_f32_32x32x16_bf16(PAF(2),VFR(2),o[0],0,0,0), C1,0); \
    KRD(GL,3); GAPB(o[1]=__builtin_amdgcn_mfma_f32_32x32x16_bf16(PAF(2),VFR(6),o[1],0,0,0), C1,4); \
    GAPB(o[0]=__builtin_amdgcn_mfma_f32_32x32x16_bf16(PAF(3),VFR(3),o[0],0,0,0), C1,8); \
    GAPB(o[1]=__builtin_amdgcn_mfma_f32_32x32x16_bf16(PAF(3),VFR(7),o[1],0,0,0), C1,12); \
    }while(0)
  int t=1;
  #undef CMASK
  #define CMASK(P0,P1,t) do{}while(0)
  for(;t+5<NT;t+=2){
    STEP(pB0,pB1,pA0,pA1,t,true,true,true);     WAIT_BAR(2); RESC(); ROT();
    STEP(pA0,pA1,pB0,pB1,t+1,true,true,true);   WAIT_BAR(2); RESC(); ROT();
  }
  #undef CMASK
  #define CMASK(P0,P1,t) do{}while(0)
  #define ENDW(tt) do{ if((tt)+3<NT){WAIT_BAR(2);} else if((tt)+2<NT){WAIT_BAR(1);} else {WAIT_BAR(0);} }while(0)
  for(;t+1<NT;t+=2){
    STEP(pB0,pB1,pA0,pA1,t,(t+3<NT),(t+1<NT),(t+1<NT));       ENDW(t);   RESC(); ROT();
    STEP(pA0,pA1,pB0,pB1,t+1,(t+4<NT),(t+2<NT),(t+2<NT));     ENDW(t+1); RESC(); ROT();
  }
  STEP(pB0,pB1,pA0,pA1,NT-1,false,false,false); RESC();
  { float sacc=pB0[0]+pB0[1]; _Pragma("unroll") for(int r=2;r<16;++r)sacc+=pB0[r]; _Pragma("unroll") for(int r=0;r<16;++r)sacc+=pB1[r]; l_reg+=sacc;
    pw0=(u32x4){PKW(pB0,0),PKW(pB0,2),PKW(pB0,4),PKW(pB0,6)};pw1=(u32x4){PKW(pB0,8),PKW(pB0,10),PKW(pB0,12),PKW(pB0,14)};pw2=(u32x4){PKW(pB1,0),PKW(pB1,2),PKW(pB1,4),PKW(pB1,6)};pw3=(u32x4){PKW(pB1,8),PKW(pB1,10),PKW(pB1,12),PKW(pB1,14)};
    SBAR(); pv(o,vb0+sl_cur,PAF(0),PAF(1),PAF(2),PAF(3)); }
  #undef PKW
  #undef PAF
  #undef VFR
  #undef PIN
  #undef MX3
  #undef GAPA
  #undef GAPB
  #undef EX
  #undef VRD
  #undef KRD
  #undef STEP
  #undef ENDW
  {auto rr=__builtin_amdgcn_permlane32_swap(__float_as_uint(l_reg),__float_as_uint(l_reg),false,false);l_reg=__uint_as_float(rr[0])+__uint_as_float(rr[1]);}
  if(hi==0)wsf[32+r32]=l_reg;asm volatile("s_waitcnt lgkmcnt(0)":::"memory");
  float rli[16];
  #pragma unroll
  for(int r=0;r<16;++r)rli[r]=__builtin_amdgcn_rcpf(wsf[32+crow(r,hi)]);
  const long orow0=(rowbase+q0+wid*QBLK)*OP+h*D; bf16*Ow=O+orow0; const bf16*Zw=Z+orow0;
  { bf16*stg=(bf16*)(shm+LDS_OST)+wid*2048;
    #pragma unroll
    for(int r=0;r<16;++r){const int orow=crow(r,hi);
      #pragma unroll
      for(int d0=0;d0<2;++d0)stg[orow*64+d0*32+r32]=__float2bfloat16(o[d0][r]*rli[r]);}
    asm volatile("s_waitcnt lgkmcnt(0)":::"memory");
    #pragma unroll
    for(int i=0;i<4;++i){const int row=i*8+(lane>>3),ch=lane&7; const u32x4 v=*(const u32x4*)(stg+row*64+ch*8); const u32x4 z=*(const u32x4*)(Zw+(long)row*OP+ch*8);
      u32x4 w; w.x=cvtpk_s(__uint_as_float(v.x<<16)*__uint_as_float(z.x<<16),__uint_as_float(v.x&0xffff0000u)*__uint_as_float(z.x&0xffff0000u));
      w.y=cvtpk_s(__uint_as_float(v.y<<16)*__uint_as_float(z.y<<16),__uint_as_float(v.y&0xffff0000u)*__uint_as_float(z.y&0xffff0000u));
      w.z=cvtpk_s(__uint_as_float(v.z<<16)*__uint_as_float(z.z<<16),__uint_as_float(v.z&0xffff0000u)*__uint_as_float(z.z&0xffff0000u));
      w.w=cvtpk_s(__uint_as_float(v.w<<16)*__uint_as_float(z.w<<16),__uint_as_float(v.w&0xffff0000u)*__uint_as_float(z.w&0xffff0000u));
      ATTN_STORE16(Ow+(long)row*OP+ch*8,w);} }
  asm volatile("s_waitcnt lgkmcnt(0)\n\ts_barrier":::"memory");
  #undef DMA_K
  #undef DMA_V
  #undef CMASK
  #undef START
  #undef RESC
  #undef ROT
}
constexpr int ATTN_LDS_BYTES=LDS_BYTES;
struct AttnTensors { const bf16* Q; const bf16* K; const bf16* V; const bf16* Z; bf16* O; };
template<int THRL,bool FIX> __device__ __forceinline__ void attn_phase(char*lds,const AttnTensors&T,int vcu,int G,float mfix){
  for(int u=vcu;u<1024;u+=G){ const int un=(G==256)?((vcu<<2)+((u-vcu)>>8)):u;
    attn_unit<THRL,FIX>(mfix,un>>6,(un>>3)&7,un&7,T.Q,T.K,T.V,T.Z,T.O,lds); }
}
#undef SBAR
#undef WAIT_BAR
}
constexpr int NWAVES = 8;
constexpr int BATCH = 16, SEQ = 2048, DM = 1024, CTX = 256, DIN = 2816, DCONV = 512;
constexpr int M = BATCH * SEQ;
constexpr int MC = BATCH * CTX;
constexpr size_t MiB = 1u << 20;
constexpr size_t WS_MOD = 0, WS_ROPE = 1 * MiB, WS_WIN = 2 * MiB, WS_WPW = 8 * MiB, WS_WOUT = 9 * MiB, WS_CTL = 12 * MiB, WS_U = 16 * MiB, WS_UG = 88 * MiB, WS_Y = WS_U, WS_MIX = WS_U + 40 * MiB,
                 WS_Q = 120 * MiB, WS_KA = 152 * MiB, WS_VA = 162 * MiB, WS_Z = 172 * MiB, WS_END = 236 * MiB;
static_assert(WS_U + 72 * MiB == WS_UG && WS_MIX + 64 * MiB == WS_UG + 32 * MiB && WS_UG + 32 * MiB <= WS_Q, "overlay map");
constexpr size_t CTL_ZERO_BYTES = 16384;
constexpr int RING_BYTES = 131072, MISC_OFF = RING_BYTES + 320, LDS_BYTES = 147456;
#define LAS __attribute__((address_space(3)))
typedef unsigned short bf16;
typedef unsigned v4u __attribute__((ext_vector_type(4)));
typedef float f32x4 __attribute__((ext_vector_type(4)));
typedef float f32x2 __attribute__((ext_vector_type(2)));
#define LDS_WAIT() asm volatile("s_waitcnt lgkmcnt(0)" ::: "memory")
__device__ __forceinline__ unsigned pk2(float lo, float hi) { return pg8::cvt_pk_bf16(lo, hi); }
__device__ __forceinline__ float wave_sum(float v) { return pg8::wave_allsum(v); }
#define GAS __attribute__((address_space(1)))
#define RLX_AGENT __ATOMIC_RELAXED, __HIP_MEMORY_SCOPE_AGENT
#define XB_TMO      128
#define XB_XCNT(j)  (256  + 64 * (j))
#define XB_XSUB(j)  (1280 + 64 * (j))
#define XB_XGEN(j)  (2304 + 64 * (j))
#define XB_TOP      3328
#define XB_TOPGEN   3392
#define XCD_BAR_WORDS 3456
#define XB_SPIN_CAP (1u << 18)

__device__ __forceinline__ unsigned xb_ld(unsigned* p)              { return __hip_atomic_load(p, __ATOMIC_RELAXED, __HIP_MEMORY_SCOPE_AGENT); }
__device__ __forceinline__ unsigned xb_add(unsigned* p, unsigned v) { return __hip_atomic_fetch_add(p, v, __ATOMIC_RELAXED, __HIP_MEMORY_SCOPE_AGENT); }
__device__ __forceinline__ unsigned xb_xcc_id() { return (unsigned)__builtin_amdgcn_s_getreg((3 << 11) | 20) & 0xFu; }
#define XB_SPIN(cond, bar) do { unsigned _sp = 0; while (cond) { __builtin_amdgcn_s_sleep(1); \
    if ((++_sp & 255u) == 0u) { if (xb_ld(&(bar)[XB_TMO])) break; if (_sp > XB_SPIN_CAP) { atomicAdd(&(bar)[XB_TMO], 1u); break; } } } } while (0)

struct XcdBarrier {
    unsigned* bar; unsigned x;
    volatile LAS unsigned* st;
};

__device__ __forceinline__ XcdBarrier xcd_barrier_post(unsigned* bar, volatile LAS unsigned* st) {
    XcdBarrier b; b.bar = bar; b.x = xb_xcc_id(); b.st = st;
    if (threadIdx.x == 0) (void)xb_add(&bar[XB_XCNT(b.x)], 1u);
    return b;
}
__device__ __forceinline__ void xcd_barrier_complete(unsigned* bar, unsigned x, unsigned& nloc, unsigned& nx) {
    const unsigned G = gridDim.x * gridDim.y * gridDim.z;
    unsigned sum, cnt, mine, sp = 0u;
    for (;;) {
        sum = 0u; cnt = 0u; mine = 0u;
#pragma unroll
        for (unsigned j = 0; j < 16; ++j) { const unsigned c = xb_ld(&bar[XB_XCNT(j)]); sum += c; cnt += (c > 0u) ? 1u : 0u; mine = (j == x) ? c : mine; }
        if (sum == G) break;
        __builtin_amdgcn_s_sleep(1);
        if ((++sp & 255u) == 0u) { if (xb_ld(&bar[XB_TMO])) break; if (sp > XB_SPIN_CAP) { atomicAdd(&bar[XB_TMO], 1u); break; } }
    }
    nloc = mine > 0u ? mine : 1u; nx = cnt > 0u ? cnt : 1u;
}

__device__ __forceinline__ void xcd_barrier(const XcdBarrier& b) {
    asm volatile("s_waitcnt vmcnt(0)" ::: "memory");
    __syncthreads();
    if (threadIdx.x == 0) {
        unsigned* bar = b.bar;
        __builtin_amdgcn_s_waitcnt(0);
        unsigned nloc = b.st[0], nx = b.st[1];
        if (nloc == 0u) { xcd_barrier_complete(bar, b.x, nloc, nx); b.st[0] = nloc; b.st[1] = nx; }
        const unsigned old = xb_add(&bar[XB_XSUB(b.x)], 1u);
        const unsigned gen = old / nloc;
        if (old + 1u == (gen + 1u) * nloc) {
            __builtin_amdgcn_fence(__ATOMIC_RELEASE, "agent");
            asm volatile("s_waitcnt vmcnt(0)" ::: "memory");
            const unsigned og = xb_add(&bar[XB_TOP], 1u);
            const unsigned tg = og / nx;
            if (og + 1u == (tg + 1u) * nx) xb_add(&bar[XB_TOPGEN], 1u);
            else XB_SPIN(xb_ld(&bar[XB_TOPGEN]) == tg, bar);
            __builtin_amdgcn_fence(__ATOMIC_ACQUIRE, "agent");
            xb_add(&bar[XB_XGEN(b.x)], 1u);
            asm volatile("s_waitcnt vmcnt(0)" ::: "memory");
        } else {
            XB_SPIN(xb_ld(&bar[XB_XGEN(b.x)]) == gen, bar);
            __builtin_amdgcn_fence(__ATOMIC_ACQUIRE, "agent");
            asm volatile("s_waitcnt vmcnt(0)" ::: "memory");
        }
    }
    __syncthreads();
}
__device__ __forceinline__ int lmap_in(int P) {
    if (P < 768) { const int tile = P >> 8, p = P & 255, bj = p >> 7, wc = (p >> 5) & 3, j = p & 31; return tile * 256 + wc * 64 + ((j < 16) ? j : j + 16) + 16 * bj; }
    if (P >= 1280 && P < 2304) { const int q = P - 1280, T = q >> 8, p = q & 255; return (p < 128) ? (1280 + 128 * T + p) : (1792 + 128 * T + (p - 128)); }
    return P;
}
template <bool MAP> __device__ __forceinline__ void p0_transpose_item(const float* W, int K, int N, bf16* WT, LAS float* scr, int item, int lane) {
    const int nblk = N / 32, kb = item / nblk, nb = item % nblk, k0 = 64 * kb, n0 = 32 * nb;
    const int ncol = MAP ? lmap_in(n0 + (lane & 31)) : (n0 + (lane & 31));
#pragma unroll 8
    for (int i = 0; i < 32; ++i) { const int kk = 2 * i + (lane >> 5); scr[kk * 33 + (lane & 31)] = __builtin_nontemporal_load(W + (size_t)(k0 + kk) * N + ncol); }
    LDS_WAIT(); asm volatile("" ::: "memory");
    const int c = lane & 7;
#pragma unroll
    for (int j = 0; j < 4; ++j) { const int n = (lane >> 3) + 8 * j; const LAS float* s = scr + (8 * c) * 33 + n;
        v4u o; o.x = pk2(s[0 * 33], s[1 * 33]); o.y = pk2(s[2 * 33], s[3 * 33]); o.z = pk2(s[4 * 33], s[5 * 33]); o.w = pk2(s[6 * 33], s[7 * 33]);
        *(v4u*)(WT + (size_t)(n0 + n) * K + k0 + 8 * c) = o; }
    LDS_WAIT(); asm volatile("" ::: "memory");
}
__device__ __forceinline__ void mod_item(LAS unsigned char* lds, const float* c, const float* cctx, const float* wmod, const float* bmod, float* MOD, int nc, int tid) {
    LAS float* sc = (LAS float*)lds;
    LAS float* part = sc + 17 * 1024;
    const int w = tid >> 6, lane = tid & 63, col = lane & 15, kq = lane >> 4, n = nc * 16 + col, kbase = 128 * w + 32 * kq;
    float wv[32];
#pragma unroll
    for (int i = 0; i < 32; ++i) wv[i] = __builtin_nontemporal_load(wmod + (size_t)(kbase + i) * 3072 + n);
    for (int idx = tid; idx < 17 * 1024; idx += 512) { const int r = idx >> 10, k = idx & 1023; const float v = (r < 16) ? c[r * 1024 + k] : cctx[k]; sc[idx] = pg8::silu_f(v); }
    __syncthreads();
    float acc[17];
#pragma unroll
    for (int r = 0; r < 17; ++r) acc[r] = 0.f;
#pragma unroll
    for (int i = 0; i < 32; ++i) {
#pragma unroll
        for (int r = 0; r < 17; ++r) acc[r] += sc[r * 1024 + kbase + i] * wv[i]; }
#pragma unroll
    for (int r = 0; r < 17; ++r) part[((w * 4 + kq) * 17 + r) * 16 + col] = acc[r];
    __syncthreads();
    for (int idx = tid; idx < 17 * 16; idx += 512) { const int r = idx >> 4, l = idx & 15; float sum = bmod[nc * 16 + l];
#pragma unroll
        for (int p = 0; p < 32; ++p) sum += part[(p * 17 + r) * 16 + l];
        MOD[(size_t)r * 3072 + nc * 16 + l] = sum; }
    __syncthreads();
}
__device__ __forceinline__ void p1_rows(const float* x, const float* ctx, const float* normw, const float* MOD, bf16* U, int gw, int NGW, int lane) {
    for (int ch = gw; ch < (M + MC) / 4; ch += NGW) {
        const int row0 = 4 * ch; const bool isc = row0 >= M; const int b = isc ? 16 : (row0 >> 11);
        const float* src = isc ? ctx + (size_t)(row0 - M) * DM : x + (size_t)row0 * DM;
        const float* mp = MOD + (size_t)b * 3072;
        f32x4 g[4], sh[4];
#pragma unroll
        for (int j = 0; j < 4; ++j) { const int col = 4 * lane + 256 * j; const f32x4 nw = *(const f32x4*)(normw + col), scl = *(const f32x4*)(mp + 1024 + col); sh[j] = *(const f32x4*)(mp + col); g[j] = nw * (1.0f + scl); }
        f32x4 vv[4][4];
#pragma unroll
        for (int rr = 0; rr < 4; ++rr) { const f32x4* xr = (const f32x4*)(src + (size_t)rr * DM) + lane;
#pragma unroll
            for (int j = 0; j < 4; ++j) vv[rr][j] = __builtin_nontemporal_load(xr + 64 * j); }
        asm volatile("" ::: "memory");
#pragma unroll
        for (int rr = 0; rr < 4; ++rr) {
            f32x4 v[4]; float s = 0.f;
#pragma unroll
            for (int j = 0; j < 4; ++j) { v[j] = vv[rr][j]; s += (v[j].x * v[j].x + v[j].y * v[j].y) + (v[j].z * v[j].z + v[j].w * v[j].w); }
            const float rinv = rsqrtf(wave_sum(s) * (1.0f / DM) + 1e-6f);
            unsigned long long* o8 = (unsigned long long*)(U + (size_t)(row0 + rr) * DM) + lane;
#pragma unroll
            for (int j = 0; j < 4; ++j) { const f32x4 o = v[j] * rinv * g[j] + sh[j];
                o8[64 * j] = (unsigned long long)pk2(o.x, o.y) | ((unsigned long long)pk2(o.z, o.w) << 32); }
        }
    }
}
__device__ __forceinline__ void conv_phase(LAS unsigned char* lds, const bf16* UG, const float* cw, const float* cb, const float* lnw, const float* lnb, bf16* Y, int vcu, int G, int tid) {
    LAS float* tile = (LAS float*)lds;
    const int cp = tid & 255, th = tid >> 8, wv = tid >> 6, lane = tid & 63;
    f32x2 w[31];
#pragma unroll
    for (int j = 0; j < 31; ++j) w[j] = *(const f32x2*)(cw + j * 512 + 2 * cp);
    const f32x2 bias = *(const f32x2*)(cb + 2 * cp);
    for (int item = vcu; item < M / 32; item += G) {
        const int row0 = item * 32 + th * 16, t0 = row0 & 2047;
        const unsigned* ub = (const unsigned*)(UG + (size_t)(row0 - t0) * 512 + 2 * cp);
        unsigned xr[46];
#pragma unroll
        for (int r = 0; r < 46; ++r) { const int tin = t0 - 15 + r, tc = tin < 0 ? 0 : (tin > 2047 ? 2047 : tin); xr[r] = ub[(size_t)tc * 256]; }
        f32x2 acc[16];
#pragma unroll
        for (int i = 0; i < 16; ++i) acc[i] = (f32x2){0.f, 0.f};
#pragma unroll
        for (int r = 0; r < 46; ++r) {
            const int tin = t0 - 15 + r; const bool ok = (tin >= 0) && (tin < 2048);
            const f32x2 xv = (f32x2){ok ? pg8::bf_lo(xr[r]) : 0.f, ok ? pg8::bf_hi(xr[r]) : 0.f};
#pragma unroll
            for (int i = 0; i < 16; ++i) { const int j = r - i; if (j >= 0 && j <= 30) acc[i] += xv * w[j]; }
        }
#pragma unroll
        for (int i = 0; i < 16; ++i) *(LAS f32x2*)(tile + (th * 16 + i) * 512 + 2 * cp) = acc[i] + bias;
        __syncthreads();
        const f32x4 lw0 = *(const f32x4*)(lnw + 8 * lane), lw1 = *(const f32x4*)(lnw + 8 * lane + 4), lb0 = *(const f32x4*)(lnb + 8 * lane), lb1 = *(const f32x4*)(lnb + 8 * lane + 4);
#pragma unroll
        for (int rr = 0; rr < 4; ++rr) {
            const int row = 4 * wv + rr;
            const f32x4 a = *(const LAS f32x4*)(tile + row * 512 + 8 * lane), b = *(const LAS f32x4*)(tile + row * 512 + 8 * lane + 4);
            const float mean = wave_sum((a.x + a.y) + (a.z + a.w) + (b.x + b.y) + (b.z + b.w)) * (1.0f / 512.0f);
            const f32x4 da = a - mean, db = b - mean;
            const float var = wave_sum((da.x * da.x + da.y * da.y) + (da.z * da.z + da.w * da.w) + (db.x * db.x + db.y * db.y) + (db.z * db.z + db.w * db.w)) * (1.0f / 512.0f);
            const float rstd = rsqrtf(var + 1e-6f);
            const f32x4 ya = da * rstd * lw0 + lb0, yb = db * rstd * lw1 + lb1;
            v4u o; o.x = pk2(pg8::silu_f(ya.x), pg8::silu_f(ya.y)); o.y = pk2(pg8::silu_f(ya.z), pg8::silu_f(ya.w)); o.z = pk2(pg8::silu_f(yb.x), pg8::silu_f(yb.y)); o.w = pk2(pg8::silu_f(yb.z), pg8::silu_f(yb.w));
            *(v4u*)(Y + (size_t)(item * 32 + row) * 512 + 8 * lane) = o;
        }
        __syncthreads();
    }
}

#ifndef MK_N_LAUNCHES
#define MK_N_LAUNCHES 1
#endif
constexpr int N_PHASES = 6;
struct Args { const float* in[17]; float* out; unsigned char* ws; int ph_lo, ph_hi; };
__global__ void __launch_bounds__(NWAVES * 64, 2) hybrid_fwd(Args args) {
    extern __shared__ __attribute__((aligned(16))) unsigned char lds[];
    LAS unsigned char* ldsl = (LAS unsigned char*)lds;
    const int tid = threadIdx.x, lane = tid & 63, wave = __builtin_amdgcn_readfirstlane(tid >> 6);
    const int G = gridDim.x, bx = blockIdx.x, vcu = (G % 8 == 0) ? (bx % 8) * (G / 8) + bx / 8 : bx;
    const int gw = vcu * NWAVES + wave, NGW = G * NWAVES;
    unsigned char* ws = args.ws;
    const float *x = args.in[0], *cvec = args.in[1], *ctx = args.in[2], *cctx = args.in[3], *wmod = args.in[4], *bmod = args.in[5], *normw = args.in[6], *win = args.in[7],
                *qnw = args.in[8], *knw = args.in[9], *convw = args.in[10], *convb = args.in[11], *lnw = args.in[12], *lnb = args.in[13], *wpw = args.in[14], *bpw = args.in[15], *wout = args.in[16];
    float* MOD = (float*)(ws + WS_MOD); float* ROPE = (float*)(ws + WS_ROPE);
    bf16 *WIN_T = (bf16*)(ws + WS_WIN), *WPW_T = (bf16*)(ws + WS_WPW), *WOUT_T = (bf16*)(ws + WS_WOUT), *U = (bf16*)(ws + WS_U), *Q = (bf16*)(ws + WS_Q), *KA = (bf16*)(ws + WS_KA), *VA = (bf16*)(ws + WS_VA),
         *Z = (bf16*)(ws + WS_Z), *UG = (bf16*)(ws + WS_UG), *Y = (bf16*)(ws + WS_Y), *MIX = (bf16*)(ws + WS_MIX);
    const int lo = args.ph_lo, hi = args.ph_hi;
#define IN(k) (lo <= (k) && (k) < hi)
    for (int u = tid; u < (LDS_BYTES - RING_BYTES) / 4; u += NWAVES * 64) ((LAS unsigned*)(ldsl + RING_BYTES))[u] = 0u;
    __syncthreads();
    XcdBarrier bar; bar.bar = (unsigned*)(ws + WS_CTL); bar.x = 0; bar.st = nullptr;
    if (hi - lo > 1) bar = xcd_barrier_post((unsigned*)(ws + WS_CTL), (volatile LAS unsigned*)(ldsl + MISC_OFF) + 8);
    if (lo > 99) cooperative_groups::this_grid().sync();
#define SEAM(k) do { if (IN(k) && IN((k) + 1)) xcd_barrier(bar); } while (0)
#ifndef REPMASK
#define REPMASK 0
#endif
#define REPS(k) for (int rep_ = 0; rep_ < 1 + ((REPMASK >> (k)) & 1); ++rep_)

    if (IN(0)) REPS(0) {
        LAS float* scr = (LAS float*)(ldsl + wave * 16384);
        constexpr int I_IN = (DM / 64) * (DIN / 32), I_PW = (DCONV / 64) * (DCONV / 32), I_OUT = (DM / 64) * (DM / 32);
        for (int it = gw; it < I_IN + I_PW + I_OUT; it += NGW) {
            int r = it;
            if (r < I_IN) { p0_transpose_item<true>(win, DM, DIN, WIN_T, scr, r, lane); continue; } r -= I_IN;
            if (r < I_PW) { p0_transpose_item<false>(wpw, DCONV, DCONV, WPW_T, scr, r, lane); continue; } r -= I_PW;
            p0_transpose_item<false>(wout, DM, DM, WOUT_T, scr, r, lane);
        }
        { const int gt = bx * 512 + tid;
          if (gt < 1024) { const int pos = gt >> 4, f = gt & 15; const float freq = powf(10000.0f, -(float)f * (1.0f / 16.0f)); const float ang = (float)pos * freq;
              ROPE[2 * gt] = cosf(ang); ROPE[2 * gt + 1] = sinf(ang); } }
        __syncthreads();
        for (int nc = bx; nc < 192; nc += G) mod_item(ldsl, cvec, cctx, wmod, bmod, MOD, nc, tid);
    }
    SEAM(0);
    if (IN(1)) REPS(1) p1_rows(x, ctx, normw, MOD, U, gw, NGW, lane);
    SEAM(1);
    if (IN(2)) REPS(2) {
        pg8::Gemm g{U, WIN_T, M + MC, DIN, DM}; pg8::OrderIn S; S.init(G, bx);
        pg8::EpiIn E{Q, KA, VA, Z, UG, ROPE, qnw, knw};
        pg8::gemm_phase<pg8::EpiIn, pg8::OrderIn, true, true>(ldsl, g, S, E);
    }
    SEAM(2);
    if (IN(3)) REPS(3) conv_phase(ldsl, UG, convw, convb, lnw, lnb, Y, vcu, G, tid);
    SEAM(3);
    if (IN(4)) REPS(4) {
        const attn_body::AttnTensors AT{(const attn_body::bf16*)Q, (const attn_body::bf16*)KA, (const attn_body::bf16*)VA, (const attn_body::bf16*)Z, (attn_body::bf16*)MIX};
        float mq = 0.f, mk = 0.f;
        for (int d = 0; d < 64; ++d) { mq = fmaxf(mq, fabsf(qnw[d])); mk = fmaxf(mk, fabsf(knw[d])); }
        const float mfix = 1.02f * 64.0f * pg8::QC2 * mq * mk;
        if (mfix <= 60.0f) attn_body::attn_phase<8, true>((char*)lds, AT, vcu, G, mfix);
        else               attn_body::attn_phase<8, false>((char*)lds, AT, vcu, G, 0.f);
        pg8::Gemm g{Y, WPW_T, M, DCONV, DCONV}; pg8::StaticOrder S; S.init(M, DCONV, G, bx);
        pg8::EpiPw E{Z, MIX, bpw};
        pg8::gemm_phase<pg8::EpiPw, pg8::StaticOrder, true, true>(ldsl, g, S, E);
    }
    SEAM(4);
    if (IN(5)) REPS(5) {
        pg8::Gemm g{MIX, WOUT_T, M, DM, DM}; pg8::StaticOrder S; S.init(M, DM, G, bx);
        pg8::EpiOut E{x, args.out, MOD};
        pg8::gemm_phase<pg8::EpiOut, pg8::StaticOrder, true, true>(ldsl, g, S, E);
    }
#undef IN
#undef SEAM
}

extern "C" void kernel_launch(void* const* d_in, const int* in_sizes, int n_in, void* d_out, int out_size, void* d_ws, size_t ws_size, hipStream_t stream) {
    static int grid = 0;
    if (grid == 0) {
        if (n_in != 17 || in_sizes[0] != M * DM || out_size != M * DM || ws_size < WS_END) { fprintf(stderr, "kernel_launch: unexpected shapes (n_in %d, in0 %d, out %d, ws %zu); nothing launched\n", n_in, n_in > 0 ? in_sizes[0] : -1, out_size, ws_size); grid = -1; return; }
        int dev = 0, cus = 0, per_cu = 0;
        if (hipGetDevice(&dev) != hipSuccess || hipDeviceGetAttribute(&cus, hipDeviceAttributeMultiprocessorCount, dev) != hipSuccess) { grid = -1; return; }
        if (hipFuncSetAttribute((const void*)hybrid_fwd, hipFuncAttributeMaxDynamicSharedMemorySize, LDS_BYTES) != hipSuccess) { fprintf(stderr, "kernel_launch: hipFuncSetAttribute failed\n"); grid = -1; return; }
        if (hipOccupancyMaxActiveBlocksPerMultiprocessor(&per_cu, (const void*)hybrid_fwd, NWAVES * 64, LDS_BYTES) != hipSuccess || per_cu < 1) { fprintf(stderr, "kernel_launch: occupancy query says %d\n", per_cu); per_cu = 1; }
        (void)hipGetLastError();
        grid = cus * per_cu;
    }
    if (grid < 0) return;
    if (hipMemsetAsync((char*)d_ws + WS_CTL, 0, CTL_ZERO_BYTES, stream) != hipSuccess) { fprintf(stderr, "kernel_launch: memset failed\n"); return; }
    Args a{};
    for (int i = 0; i < 17; ++i) a.in[i] = (const float*)d_in[i];
    a.out = (float*)d_out; a.ws = (unsigned char*)d_ws;
#if MK_N_LAUNCHES == 1
    a.ph_lo = 0; a.ph_hi = N_PHASES;
    void* kargs[] = {&a};
    hipError_t e = hipLaunchCooperativeKernel((const void*)hybrid_fwd, dim3(grid), dim3(NWAVES * 64), kargs, LDS_BYTES, stream);
    if (e != hipSuccess) fprintf(stderr, "kernel_launch: cooperative launch failed: %s (grid %d)\n", hipGetErrorString(e), grid);
#else
    for (int p = 0; p < N_PHASES; ++p) { a.ph_lo = p; a.ph_hi = p + 1; hipLaunchKernelGGL(hybrid_fwd, dim3(grid), dim3(NWAVES * 64), LDS_BYTES, stream, a); }
#endif
}
```
